# Optimizing an MI355X kernel written in HIP

```python
import math
import jax
import jax.numpy as jnp
from jax import lax
import numpy as np

D_MODEL = 1024
BATCH = 16
SEQ = 2048
DEPTH = 1

BLOCK = 128
EPS = 1e-6

MLA_HEADS = 8
MLA_NOPE = 64
MLA_ROPE = 32
MLA_V = 64
MLA_KV_RANK = 256
ROPE_THETA = 10000.0

DIL_PATTERNS = ((128, 1), (512, 4), (2048, 16))
N_DIL_GROUPS = 3
DIL_HEADS = 8
DIL_HEAD_DIM = 64

N_EXPERT_GROUPS = 4
EXPERTS_PER_GROUP = 8
N_EXPERTS = N_EXPERT_GROUPS * EXPERTS_PER_GROUP
TOP_K_EXPERT = 2
D_FF_EXPERT = 256

MLA_Q_COLS = MLA_HEADS * (MLA_NOPE + MLA_ROPE)
DIL_COLS = 3 * N_DIL_GROUPS * DIL_HEADS * DIL_HEAD_DIM
GATE_COLS = 2 * D_MODEL
IN_COLS = MLA_Q_COLS + MLA_KV_RANK + MLA_ROPE + DIL_COLS + GATE_COLS

kernel_name = 'hybrid_mla_dilated_gated_hmoe'


def rms_norm(x, g):
    xf = x.astype(jnp.float32)
    y = xf * lax.rsqrt(jnp.mean(xf * xf, axis=-1, keepdims=True) + EPS)
    return (y * g.astype(jnp.float32)).astype(x.dtype)


def alibi_slopes(n):
    return jnp.exp2(-8.0 * (jnp.arange(n, dtype=jnp.float32) + 1.0) / n)


def rope(t, positions):
    half = t.shape[-1] // 2
    freqs = ROPE_THETA ** (-jnp.arange(half, dtype=jnp.float32) / half)
    ang = positions.astype(jnp.float32)[:, :, None] * freqs
    cos = jnp.cos(ang)[:, :, None, :]
    sin = jnp.sin(ang)[:, :, None, :]
    t1 = t[..., :half].astype(jnp.float32)
    t2 = t[..., half:].astype(jnp.float32)
    return jnp.concatenate([t1 * cos - t2 * sin, t2 * cos + t1 * sin], axis=-1).astype(t.dtype)


def causal_block_attention(q, k, v, scale):
    B, S, H, dq = q.shape
    nb = S // BLOCK
    q_blocks = jnp.moveaxis(q.reshape(B, nb, BLOCK, H, dq), 1, 0)
    kpos = jnp.arange(S)

    def one_block(args):
        qb, bi = args
        s = jnp.einsum('bqhd,bkhd->bhqk', qb, k).astype(jnp.float32) * scale
        qpos = bi * BLOCK + jnp.arange(BLOCK)
        s = jnp.where(kpos[None, :] <= qpos[:, None], s, -jnp.inf)
        p = jax.nn.softmax(s, axis=-1)
        return jnp.einsum('bhqk,bkhd->bqhd', p.astype(v.dtype), v)

    o = lax.map(one_block, (q_blocks, jnp.arange(nb)))
    return jnp.moveaxis(o, 0, 1).reshape(B, S, H, v.shape[-1])


def banded_attention(q, k, v, n_back, stride, slopes, scale):
    assert n_back <= BLOCK
    N, L, H, dh = q.shape
    nb = -(-L // BLOCK)
    Lp = nb * BLOCK
    qb = jnp.pad(q, ((0, 0), (0, Lp - L), (0, 0), (0, 0))).reshape(N, nb, BLOCK, H, dh)

    def key_blocks(t):
        tp = jnp.pad(t, ((0, 0), (BLOCK, Lp - L), (0, 0), (0, 0)))
        prev = tp[:, :Lp].reshape(N, nb, BLOCK, H, dh)
        cur = tp[:, BLOCK:].reshape(N, nb, BLOCK, H, dh)
        return jnp.concatenate([prev, cur], axis=2)

    kb = key_blocks(k)
    vb = key_blocks(v)
    s = jnp.einsum('nbqhd,nbkhd->nbhqk', qb, kb).astype(jnp.float32) * scale
    i = jnp.arange(BLOCK)[:, None]
    j = jnp.arange(2 * BLOCK)[None, :]
    delta = i + BLOCK - j
    kpos = jnp.arange(nb)[:, None, None] * BLOCK - BLOCK + j[None]
    valid = (delta >= 0) & (delta <= n_back) & (kpos >= 0)
    bias = -slopes[:, None, None] * (delta * stride).astype(jnp.float32)
    s = jnp.where(valid[None, :, None], s + bias, -jnp.inf)
    m = jnp.max(s, axis=-1, keepdims=True)
    p = jnp.exp(s - m)
    den = jnp.sum(p, axis=-1, keepdims=True)
    o = jnp.einsum('nbhqk,nbkhd->nbqhd', (p / den).astype(v.dtype), vb)
    o = o.reshape(N, Lp, H, dh)[:, :L]
    lse = jnp.transpose((m + jnp.log(den))[..., 0], (0, 1, 3, 2)).reshape(N, Lp, H)[:, :L]
    return o, lse


def mla_branch(q_cols, ckv, k_rope, positions, norm_ckv, w_ukv, q_norm, k_norm):
    B, S, _ = q_cols.shape
    q = q_cols.reshape(B, S, MLA_HEADS, MLA_NOPE + MLA_ROPE)
    kv = (rms_norm(ckv, norm_ckv) @ w_ukv).reshape(B, S, MLA_HEADS, MLA_NOPE + MLA_V)
    k_nope, v = kv[..., :MLA_NOPE], kv[..., MLA_NOPE:]
    k = jnp.concatenate([k_nope, jnp.broadcast_to(k_rope[:, :, None, :], (B, S, MLA_HEADS, MLA_ROPE))], axis=-1)
    q = rms_norm(q, q_norm)
    k = rms_norm(k, k_norm)
    q = jnp.concatenate([q[..., :MLA_NOPE], rope(q[..., MLA_NOPE:], positions)], axis=-1)
    k = jnp.concatenate([k[..., :MLA_NOPE], rope(k[..., MLA_NOPE:], positions)], axis=-1)
    o = causal_block_attention(q, k, v, (MLA_NOPE + MLA_ROPE) ** -0.5)
    return o.reshape(B, S, MLA_HEADS * MLA_V)


def dilated_branch(qkv_cols, q_norm, k_norm):
    B, S, _ = qkv_cols.shape
    H, dh = DIL_HEADS, DIL_HEAD_DIM
    qkv = qkv_cols.reshape(B, S, 3, N_DIL_GROUPS, H, dh)
    q = rms_norm(qkv[:, :, 0], q_norm[:, None, :])
    k = rms_norm(qkv[:, :, 1], k_norm[:, None, :])
    v = qkv[:, :, 2]
    slopes = alibi_slopes(H)
    outs, lses = [], []
    for g, (window, dil) in enumerate(DIL_PATTERNS):
        L = S // dil
        def fold(t):
            return t[:, :, g].reshape(B, L, dil, H, dh).transpose(0, 2, 1, 3, 4).reshape(B * dil, L, H, dh)
        o, lse = banded_attention(fold(q), fold(k), fold(v), window // dil, dil, slopes, dh ** -0.5)
        outs.append(o.reshape(B, dil, L, H, dh).transpose(0, 2, 1, 3, 4).reshape(B, S, H, dh))
        lses.append(lse.reshape(B, dil, L, H).transpose(0, 2, 1, 3).reshape(B, S, H))
    w = jax.nn.softmax(jnp.stack(lses, axis=0), axis=0)
    o = jnp.sum(w[..., None] * jnp.stack(outs, axis=0).astype(jnp.float32), axis=0)
    return o.astype(qkv_cols.dtype).reshape(B, S, H * dh)


def hier_moe(h, w_rg, b_rg, w_re, b_re, w_gate, w_up, w_down):
    B, S, D = h.shape
    T = B * S
    hf = h.reshape(T, D)
    gp = jax.nn.softmax((hf @ w_rg + b_rg).astype(jnp.float32), axis=-1)
    g_p, g_i = lax.top_k(gp, 1)
    g_p, g_i = g_p[:, 0], g_i[:, 0]
    el = (hf @ w_re + b_re).astype(jnp.float32).reshape(T, N_EXPERT_GROUPS, EXPERTS_PER_GROUP)
    el_sel = el[jnp.arange(T), g_i]
    ep = jax.nn.softmax(el_sel, axis=-1)
    e_p, e_i = lax.top_k(ep, TOP_K_EXPERT)
    e_p = e_p / jnp.sum(e_p, axis=-1, keepdims=True)
    weights = g_p[:, None] * e_p
    expert_idx = g_i[:, None] * EXPERTS_PER_GROUP + e_i
    combine = jnp.sum(jax.nn.one_hot(expert_idx, N_EXPERTS, dtype=jnp.float32) * weights[..., None], axis=1)
    combine = combine.astype(hf.dtype)
    y = jnp.zeros_like(hf)
    for e in range(N_EXPERTS):
        he = jax.nn.silu(hf @ w_gate[e]) * (hf @ w_up[e])
        y = y + combine[:, e:e + 1] * (he @ w_down[e])
    return y.reshape(B, S, D)


def setup_inputs(seed: int = 0) -> dict:
    key = jax.random.key(seed)
    ks = jax.random.split(key, 24)

    def nrm(k, shape, fan_in):
        return jax.random.normal(k, shape, jnp.float32) * (fan_in ** -0.5)

    def gain(k, shape):
        return 1.0 + 0.02 * jax.random.normal(k, shape, jnp.float32)

    def bias(k, shape, scale):
        return scale * jax.random.normal(k, shape, jnp.float32)

    Ld = DEPTH
    return {
        'x': jax.random.normal(ks[0], (BATCH, SEQ, D_MODEL), jnp.float32),
        'positions': jnp.broadcast_to(jnp.arange(SEQ, dtype=jnp.int32), (BATCH, SEQ)),
        'norm_attn': gain(ks[1], (Ld, D_MODEL)),
        'w_in': nrm(ks[2], (Ld, D_MODEL, IN_COLS), D_MODEL),
        'b_gate': bias(ks[3], (Ld, 2, D_MODEL), 0.02),
        'norm_ckv': gain(ks[4], (Ld, MLA_KV_RANK)),
        'w_ukv': nrm(ks[5], (Ld, MLA_KV_RANK, MLA_HEADS * (MLA_NOPE + MLA_V)), MLA_KV_RANK),
        'q_norm_mla': gain(ks[6], (Ld, MLA_NOPE + MLA_ROPE)),
        'k_norm_mla': gain(ks[7], (Ld, MLA_NOPE + MLA_ROPE)),
        'q_norm_dil': gain(ks[8], (Ld, N_DIL_GROUPS, DIL_HEAD_DIM)),
        'k_norm_dil': gain(ks[9], (Ld, N_DIL_GROUPS, DIL_HEAD_DIM)),
        'w_o_mla': nrm(ks[10], (Ld, MLA_HEADS * MLA_V, D_MODEL), MLA_HEADS * MLA_V),
        'w_o_dil': nrm(ks[11], (Ld, DIL_HEADS * DIL_HEAD_DIM, D_MODEL), DIL_HEADS * DIL_HEAD_DIM),
        'w_out': nrm(ks[12], (Ld, D_MODEL, D_MODEL), D_MODEL),
        'norm_ffn': gain(ks[13], (Ld, D_MODEL)),
        'w_router_group': nrm(ks[14], (Ld, D_MODEL, N_EXPERT_GROUPS), D_MODEL),
        'b_router_group': bias(ks[15], (Ld, N_EXPERT_GROUPS), 0.01),
        'w_router_expert': nrm(ks[16], (Ld, D_MODEL, N_EXPERTS), D_MODEL),
        'b_router_expert': bias(ks[17], (Ld, N_EXPERTS), 0.01),
        'w_gate': nrm(ks[18], (Ld, N_EXPERTS, D_MODEL, D_FF_EXPERT), D_MODEL),
        'w_up': nrm(ks[19], (Ld, N_EXPERTS, D_MODEL, D_FF_EXPERT), D_MODEL),
        'w_down': nrm(ks[20], (Ld, N_EXPERTS, D_FF_EXPERT, D_MODEL), D_FF_EXPERT),
    }


def reference(x, positions, norm_attn, w_in, b_gate, norm_ckv, w_ukv, q_norm_mla, k_norm_mla,
              q_norm_dil, k_norm_dil, w_o_mla, w_o_dil, w_out, norm_ffn, w_router_group,
              b_router_group, w_router_expert, b_router_expert, w_gate, w_up, w_down):
    B, S, D = x.shape
    splits = [MLA_Q_COLS, MLA_Q_COLS + MLA_KV_RANK, MLA_Q_COLS + MLA_KV_RANK + MLA_ROPE,
              MLA_Q_COLS + MLA_KV_RANK + MLA_ROPE + DIL_COLS]
    for l in range(DEPTH):
        h = rms_norm(x, norm_attn[l])
        proj = h @ w_in[l]
        q_mla, ckv, k_rope, qkv_dil, gate_pre = jnp.split(proj, splits, axis=-1)
        o_mla = mla_branch(q_mla, ckv, k_rope, positions, norm_ckv[l], w_ukv[l],
                           q_norm_mla[l], k_norm_mla[l])
        o_dil = dilated_branch(qkv_dil, q_norm_dil[l], k_norm_dil[l])
        gates = jax.nn.sigmoid(gate_pre.reshape(B, S, 2, D) + b_gate[l])
        merged = gates[:, :, 0] * (o_mla @ w_o_mla[l]) + gates[:, :, 1] * (o_dil @ w_o_dil[l])
        x = x + merged @ w_out[l]
        h2 = rms_norm(x, norm_ffn[l])
        x = x + hier_moe(h2, w_router_group[l], b_router_group[l], w_router_expert[l],
                         b_router_expert[l], w_gate[l], w_up[l], w_down[l])
    return x
```

```cpp
#include <hip/hip_runtime.h>
#include <hip/hip_bf16.h>
#include <cstdio>
#include <cstdint>
#include <cmath>

#ifndef DBG_GATE_EXPR
#define DBG_GATE_EXPR fast_sigmoid(v[e] + bv[e])
#endif
#define GAS __attribute__((address_space(1)))
#define LAS __attribute__((address_space(3)))
typedef unsigned short bf16_t;
typedef short bf16x8 __attribute__((ext_vector_type(8)));
typedef short s16x4 __attribute__((ext_vector_type(4)));
typedef float f32x2 __attribute__((ext_vector_type(2)));
typedef float f32x4 __attribute__((ext_vector_type(4)));
typedef float f32x16 __attribute__((ext_vector_type(16)));
typedef unsigned u32x2 __attribute__((ext_vector_type(2)));
typedef unsigned u32x4 __attribute__((ext_vector_type(4)));
typedef GAS unsigned gu32;
typedef GAS unsigned long long gu64;
#define RLX_AGENT __ATOMIC_RELAXED, __HIP_MEMORY_SCOPE_AGENT
#define LDS_WAIT() asm volatile("s_waitcnt lgkmcnt(0)" ::: "memory")
#define VM_WAIT() asm volatile("s_waitcnt vmcnt(0)" ::: "memory")
#define SBAR() __builtin_amdgcn_sched_barrier(0)

constexpr int D_MODEL = 1024, BATCH = 16, SEQ = 2048, T_TOK = BATCH * SEQ;
constexpr int IN_COLS = 7712;
constexpr int N1_TILES = 31, N1_PAD = N1_TILES * 256;
constexpr float EPS = 1e-6f, LOG2E = 1.4426950408889634f;
constexpr int NEXP = 32, EPG = 8, NGRP = 4, DFF = 256, LIST_CAP = T_TOK;
constexpr int LD_QM = 768, LD_CK = 320, LD_DIL = 1536, LD_G = 2048, LD_KM = 768, LD_VM = 512;
constexpr float QS_DIL = 0.125f * LOG2E;
constexpr float QS_MLA = 0.10206207261596575f * LOG2E;

typedef __bf16 bf16x2_t __attribute__((ext_vector_type(2)));
__device__ __forceinline__ unsigned cvt_pk_bf16(float lo, float hi) { f32x2 v = {lo, hi}; bf16x2_t b = __builtin_convertvector(v, bf16x2_t); return __builtin_bit_cast(unsigned, b); }
__device__ __forceinline__ float bf2f(unsigned short u) { return __uint_as_float(((unsigned)u) << 16); }
__device__ __forceinline__ float bflo(unsigned w) { return __uint_as_float(w << 16); }
__device__ __forceinline__ float bfhi(unsigned w) { return __uint_as_float(w & 0xffff0000u); }
__device__ __forceinline__ void unpack8(const u32x4 w, float* f) { f[0] = bflo(w.x); f[1] = bfhi(w.x); f[2] = bflo(w.y); f[3] = bfhi(w.y); f[4] = bflo(w.z); f[5] = bfhi(w.z); f[6] = bflo(w.w); f[7] = bfhi(w.w); }
__device__ __forceinline__ u32x4 pack8(const float* f) { u32x4 w; w.x = cvt_pk_bf16(f[0], f[1]); w.y = cvt_pk_bf16(f[2], f[3]); w.z = cvt_pk_bf16(f[4], f[5]); w.w = cvt_pk_bf16(f[6], f[7]); return w; }
__device__ __forceinline__ float fast_sigmoid(float z) { return __builtin_amdgcn_rcpf(1.0f + __builtin_amdgcn_exp2f(-z * LOG2E)); }
__device__ __forceinline__ float wave_sum(float v) {
#pragma unroll
    for (int o = 1; o < 64; o <<= 1) v += __shfl_xor(v, o);
    return v;
}
namespace pg8 {
#define PG8_LAS __attribute__((address_space(3)))
constexpr int BM = 256, BK = 64, HALF = 128, HTB = HALF * BK * 2  , STAGE_BYTES = 8 * HTB, NXCD = 8, WGM = 8;

__host__ __device__ __forceinline__ int lds_byte(int r, int c) { const int st = (r >> 4) * 2 + (c >> 5), rr = r & 15, cc = c & 31, ob = rr * 64 + cc * 2; return st * 1024 + (ob ^ (((ob >> 9) & 1) << 5)); }
__host__ __device__ __forceinline__ void stage_rc(int b, int& R, int& C) { const int st = b / 1024, sb = b % 1024, swz = sb ^ (((sb >> 9) & 1) << 5); R = (st >> 1) * 16 + swz / 64; C = (st & 1) * 32 + (swz % 64) / 2; }
__host__ __device__ __forceinline__ int perm32(int rho) { const int n = rho >> 4, i = rho & 15; return 8 * (i >> 2) + 4 * n + (i & 3); }

struct Unit { int pm, pn, aux; };
struct Gemm { const bf16_t* A; const bf16_t* Bt; int lda, ldb, K; int kstepA; };

struct StaticOrder {
    int nM, nN, nwg, G, c;
    __host__ __device__ void init(int M, int N, int G_, int c_) { nM = M / BM; nN = N / BM; nwg = nM * nN; G = G_; c = c_; }
    __host__ __device__ bool next(int i, Unit& u) const {
        const long L = (long)i * G + c; if (L >= nwg) return false;
        int wgid = (int)L; { const int q = nwg / NXCD, r = nwg % NXCD, xcd = wgid % NXCD, off = wgid / NXCD; wgid = (xcd < r ? xcd * (q + 1) : r * (q + 1) + (xcd - r) * q) + off; }
        const int nig = WGM * nN, gid = wgid / nig, fm = gid * WGM, gsz = (nM - fm) < WGM ? (nM - fm) : WGM;
        u.pm = fm + ((wgid % nig) % gsz); u.pn = (wgid % nig) / gsz; u.aux = 0; return true;
    }
    __device__ __forceinline__ unsigned row_off(const Unit&, int) const { return 0u; }
};

template <class Epi, class Sched, bool ALIGN_EPI, bool GATHER>
__device__ __forceinline__ void gemm_phase(PG8_LAS unsigned char* lds, const Gemm g, const Sched& S, const Epi& E) {
    const int tid = threadIdx.x, wid = __builtin_amdgcn_readfirstlane(tid >> 6), lane = tid & 63, wr = wid >> 2, wc = wid & 3, fr = lane & 15, fq = lane >> 4;
    const int K = g.K, nt = K / BK;
    unsigned voffB[2]; unsigned vcur[2][2], vnxt[2][2]; int Rr[2], Cc[2];
#pragma unroll
    for (int i = 0; i < 2; ++i) { int R, C; stage_rc(tid * 16 + i * 8192, R, C); const int Rb = Epi::PERM ? ((R & ~31) + perm32(R & 31)) : R;
        Rr[i] = R; Cc[i] = C; voffB[i] = (unsigned)(Rb * g.ldb + C) * 2u;
        vcur[0][i] = (unsigned)(R * g.lda + C) * 2u; vcur[1][i] = (unsigned)((R + HALF) * g.lda + C) * 2u; vnxt[0][i] = vcur[0][i]; vnxt[1][i] = vcur[1][i]; }
    const size_t kstepA = (size_t)g.kstepA, kstepB = (size_t)(BK * 2);
    const size_t hstepB = (size_t)HALF * g.ldb * 2, tstepB = 2 * hstepB, tstepA = (size_t)BM * g.lda * 2;
    const unsigned ldsw = (unsigned)wid * 1024u;
    const int aoff = lds_byte(wr * 64 + fr, fq * 8), boff = lds_byte(wc * 32 + fr, fq * 8);
#define PG8_SA(b, h) (((b) * 2 + (h)) * HTB)
#define PG8_SB(b, h) ((4 + (b) * 2 + (h)) * HTB)
#define PG8_STAGE(bufoff, gbase, voff) do { _Pragma("unroll") for (int _i = 0; _i < 2; ++_i) \
        __builtin_amdgcn_global_load_lds((const unsigned*)((const char*)(gbase) + (voff)[_i]), (PG8_LAS unsigned*)(lds + (bufoff) + ldsw + _i * 8192), 16, 0, 0); } while (0)
#define PG8_LDA(dst, b, h) do { _Pragma("unroll") for (int m = 0; m < 4; ++m) _Pragma("unroll") for (int k = 0; k < 2; ++k) dst[m][k] = *(const PG8_LAS bf16x8*)(lds + PG8_SA(b, h) + aoff + m * 2048 + k * 1024); } while (0)
#define PG8_LDB(dst, b, h) do { _Pragma("unroll") for (int n = 0; n < 2; ++n) _Pragma("unroll") for (int k = 0; k < 2; ++k) dst[n][k] = *(const PG8_LAS bf16x8*)(lds + PG8_SB(b, h) + boff + n * 2048 + k * 1024); } while (0)
#define PG8_MMA(ai, bj, At, Bt) do { __builtin_amdgcn_s_setprio(1); _Pragma("unroll") for (int m = 0; m < 4; ++m) _Pragma("unroll") for (int n = 0; n < 2; ++n) _Pragma("unroll") for (int k = 0; k < 2; ++k) \
        acc[ai][bj][m][n] = __builtin_amdgcn_mfma_f32_16x16x32_bf16(Bt[n][k], At[m][k], acc[ai][bj][m][n], 0, 0, 0); __builtin_amdgcn_s_setprio(0); } while (0)
#define PG8_WAIT_V(n) asm volatile("s_waitcnt vmcnt(" #n ")" ::: "memory")
#define PG8_WAIT_L(n) asm volatile("s_waitcnt lgkmcnt(" #n ")" ::: "memory")
#define PG8_BAR __builtin_amdgcn_s_barrier()
#define PG8_SCHED __builtin_amdgcn_sched_barrier(0)
    Unit cur, nxt; int ui = 0;
    if (!S.next(0, cur)) return;
    if constexpr (GATHER) {
#pragma unroll
        for (int h = 0; h < 2; ++h)
#pragma unroll
            for (int i = 0; i < 2; ++i) { vcur[h][i] = S.row_off(cur, h * HALF + Rr[i]) + (unsigned)Cc[i] * 2u; vnxt[h][i] = vcur[h][i]; }
    }
    f32x4 acc[2][2][4][2];
#pragma unroll
    for (int a = 0; a < 2; ++a)
#pragma unroll
        for (int b = 0; b < 2; ++b)
#pragma unroll
            for (int m = 0; m < 4; ++m)
#pragma unroll
                for (int n = 0; n < 2; ++n) acc[a][b][m][n] = (f32x4){0.f, 0.f, 0.f, 0.f};
    bf16x8 At[4][2], B0[2][2], B1[2][2];
    const char* cA = (const char*)g.A + (GATHER ? (size_t)0 : (size_t)cur.pm * tstepA); const char* cB = (const char*)g.Bt + (size_t)cur.pn * tstepB;
    PG8_STAGE(PG8_SB(0, 0), cB, voffB); PG8_STAGE(PG8_SB(0, 1), cB + hstepB, voffB); PG8_STAGE(PG8_SA(0, 0), cA, vcur[0]); PG8_STAGE(PG8_SA(0, 1), cA, vcur[1]);
    if (wr == 1) PG8_BAR;
    PG8_WAIT_V(2); PG8_BAR;
    PG8_STAGE(PG8_SB(1, 0), cB + kstepB, voffB); PG8_STAGE(PG8_SA(1, 0), cA + kstepA, vcur[0]); PG8_STAGE(PG8_SB(1, 1), cB + hstepB + kstepB, voffB);
    PG8_WAIT_V(6); PG8_BAR;
    for (;;) {
        const bool has_next = S.next(ui + 1, nxt);
        const char* nA = has_next ? (const char*)g.A + (GATHER ? (size_t)0 : (size_t)nxt.pm * tstepA) : cA; const char* nB = has_next ? (const char*)g.Bt + (size_t)nxt.pn * tstepB : cB;
        if constexpr (GATHER) {
            if (has_next) {
#pragma unroll
                for (int h = 0; h < 2; ++h)
#pragma unroll
                    for (int i = 0; i < 2; ++i) vnxt[h][i] = S.row_off(nxt, h * HALF + Rr[i]) + (unsigned)Cc[i] * 2u;
            } else {
#pragma unroll
                for (int h = 0; h < 2; ++h)
#pragma unroll
                    for (int i = 0; i < 2; ++i) vnxt[h][i] = vcur[h][i];
            }
        }
#pragma unroll 1
        for (int t = 0; t < nt; t += 2) {
            const bool last = (t == nt - 2);
            const char* a1 = cA + (size_t)(t + 1) * kstepA;
            const char* a2 = last ? nA : cA + (size_t)(t + 2) * kstepA; const char* b2 = last ? nB : cB + (size_t)(t + 2) * kstepB;
            const char* a3 = a2 + kstepA; const char* b3 = b2 + kstepB;
            unsigned vsel[2][2];
#pragma unroll
            for (int h = 0; h < 2; ++h)
#pragma unroll
                for (int i = 0; i < 2; ++i) vsel[h][i] = (GATHER && last) ? vnxt[h][i] : vcur[h][i];
            PG8_LDB(B0, 0, 0); PG8_LDB(B1, 0, 1); PG8_SCHED; PG8_LDA(At, 0, 0); PG8_STAGE(PG8_SA(1, 1), a1, vcur[1]);
            PG8_WAIT_V(8); PG8_WAIT_L(0); PG8_BAR; PG8_MMA(0, 0, At, B0); PG8_MMA(0, 1, At, B1); PG8_BAR; PG8_SCHED;
            PG8_LDA(At, 0, 1); PG8_STAGE(PG8_SB(0, 0), b2, voffB); PG8_STAGE(PG8_SB(0, 1), b2 + hstepB, voffB); PG8_STAGE(PG8_SA(0, 0), a2, vsel[0]);
            PG8_WAIT_V(8); PG8_WAIT_L(0); PG8_BAR; PG8_MMA(1, 0, At, B0); PG8_MMA(1, 1, At, B1); PG8_BAR; PG8_SCHED;
            PG8_LDB(B0, 1, 0); PG8_LDB(B1, 1, 1); PG8_SCHED; PG8_LDA(At, 1, 0); PG8_STAGE(PG8_SA(0, 1), a2, vsel[1]);
            PG8_WAIT_V(8); PG8_WAIT_L(0); PG8_BAR; PG8_MMA(0, 0, At, B0); PG8_MMA(0, 1, At, B1); PG8_BAR; PG8_SCHED;
            PG8_LDA(At, 1, 1); PG8_STAGE(PG8_SB(1, 0), b3, voffB); PG8_STAGE(PG8_SB(1, 1), b3 + hstepB, voffB); PG8_STAGE(PG8_SA(1, 0), a3, vsel[0]);
            PG8_WAIT_V(8); PG8_WAIT_L(0); PG8_BAR; PG8_MMA(1, 0, At, B0); PG8_MMA(1, 1, At, B1); PG8_BAR; PG8_SCHED;
        }
        if constexpr (ALIGN_EPI) { if (wr == 0) PG8_BAR; }
        E(acc, cur, wr, wc, fr, fq);
        if (!has_next) break;
#pragma unroll
        for (int a = 0; a < 2; ++a)
#pragma unroll
            for (int b = 0; b < 2; ++b)
#pragma unroll
                for (int m = 0; m < 4; ++m)
#pragma unroll
                    for (int n = 0; n < 2; ++n) acc[a][b][m][n] = (f32x4){0.f, 0.f, 0.f, 0.f};
        cur = nxt; cA = nA; cB = nB; ++ui;
        if constexpr (GATHER) {
#pragma unroll
            for (int h = 0; h < 2; ++h)
#pragma unroll
                for (int i = 0; i < 2; ++i) vcur[h][i] = vnxt[h][i];
        }
        if constexpr (ALIGN_EPI) { if (wr == 1) PG8_BAR; }
    }
    PG8_WAIT_V(0);
    if constexpr (!ALIGN_EPI) { if (wr == 0) PG8_BAR; }
    PG8_BAR;
#undef PG8_SA
#undef PG8_SB
#undef PG8_STAGE
#undef PG8_LDA
#undef PG8_LDB
#undef PG8_MMA
#undef PG8_WAIT_V
#undef PG8_WAIT_L
#undef PG8_BAR
#undef PG8_SCHED
}
}
constexpr size_t MiB = 1u << 20;
constexpr size_t WS_CTL = 0, CTL_ZERO_BYTES = 1 * MiB;
constexpr size_t WS_WIN = 1 * MiB;
constexpr size_t WS_WUKV = 17 * MiB;
constexpr size_t WS_WOM = 18 * MiB;
constexpr size_t WS_WOD = 19 * MiB;
constexpr size_t WS_WOUT = 20 * MiB;
constexpr size_t WS_ROPE = 22 * MiB;
constexpr size_t WS_CKS = 26 * MiB;
constexpr size_t WS_TINFO = 27 * MiB;
constexpr size_t WS_LIST = 28 * MiB;
constexpr size_t WS_B = 32 * MiB;
constexpr size_t WS_VM = 96 * MiB;
constexpr size_t WS_QM = 128 * MiB;
constexpr size_t WS_CK = 176 * MiB;
constexpr size_t WS_DQ = 196 * MiB;
constexpr size_t WS_DK = 292 * MiB;
constexpr size_t WS_DV = 388 * MiB;
constexpr size_t WS_END = 484 * MiB;
constexpr size_t WS_Y = WS_DQ;
constexpr int MAX_SLOT_ROWS = 65536 + 32 * 256;
static_assert(WS_Y + (size_t)MAX_SLOT_ROWS * 1024 * 2 <= WS_DV, "Y fits DQ|DK");
constexpr int CW_TMO = 0, CW_CODE = 1;
constexpr int CW_BAR = 4096;
constexpr int CW_CNT = 8192;

constexpr int RING_OFF = 0, RING_BYTES = 131072;
constexpr int TAB_OFF = 131072;
constexpr int LDSCTL_OFF = 147456, MISC_OFF = LDSCTL_OFF + 320;
constexpr int LDS_BYTES = 148480;
static_assert(MISC_OFF + 128 <= LDS_BYTES, "LDS map");

#define XB_TMO      128
#define XB_XCNT(j)  (256  + 64 * (j))
#define XB_XSUB(j)  (1280 + 64 * (j))
#define XB_XGEN(j)  (2304 + 64 * (j))
#define XB_TOP      3328
#define XB_TOPGEN   3392
#define XCD_BAR_WORDS 3456
#define XB_SPIN_CAP (1u << 18)

__device__ __forceinline__ unsigned xb_ld(unsigned* p)              { return __hip_atomic_load(p, __ATOMIC_RELAXED, __HIP_MEMORY_SCOPE_AGENT); }
__device__ __forceinline__ unsigned xb_add(unsigned* p, unsigned v) { return __hip_atomic_fetch_add(p, v, __ATOMIC_RELAXED, __HIP_MEMORY_SCOPE_AGENT); }
__device__ __forceinline__ unsigned xb_xcc_id() { return (unsigned)__builtin_amdgcn_s_getreg((3 << 11) | 20) & 0xFu; }
#define XB_SPIN(cond, bar) do { unsigned _sp = 0; while (cond) { __builtin_amdgcn_s_sleep(1); \
    if ((++_sp & 255u) == 0u) { if (xb_ld(&(bar)[XB_TMO])) break; if (_sp > XB_SPIN_CAP) { atomicAdd(&(bar)[XB_TMO], 1u); break; } } } } while (0)

struct XcdBarrier {
    unsigned* bar; unsigned x;
    volatile LAS unsigned* st;
};
__device__ __forceinline__ XcdBarrier xcd_barrier_post(unsigned* bar, volatile LAS unsigned* st) {
    XcdBarrier b; b.bar = bar; b.x = xb_xcc_id(); b.st = st;
    if (threadIdx.x == 0) (void)xb_add(&bar[XB_XCNT(b.x)], 1u);
    return b;
}
__device__ __forceinline__ void xcd_barrier_complete(unsigned* bar, unsigned x, unsigned& nloc, unsigned& nx) {
    const unsigned G = gridDim.x * gridDim.y * gridDim.z;
    unsigned sum, cnt, mine, sp = 0u;
    for (;;) {
        sum = 0u; cnt = 0u; mine = 0u;
#pragma unroll
        for (unsigned j = 0; j < 16; ++j) { const unsigned c = xb_ld(&bar[XB_XCNT(j)]); sum += c; cnt += (c > 0u) ? 1u : 0u; mine = (j == x) ? c : mine; }
        if (sum == G) break;
        __builtin_amdgcn_s_sleep(1);
        if ((++sp & 255u) == 0u) { if (xb_ld(&bar[XB_TMO])) break; if (sp > XB_SPIN_CAP) { atomicAdd(&bar[XB_TMO], 1u); break; } }
    }
    nloc = mine > 0u ? mine : 1u; nx = cnt > 0u ? cnt : 1u;
}
__device__ __forceinline__ void xcd_barrier(const XcdBarrier& b) {
    asm volatile("s_waitcnt vmcnt(0)" ::: "memory");
    __syncthreads();
    if (threadIdx.x == 0) {
        unsigned* bar = b.bar;
        __builtin_amdgcn_s_waitcnt(0);
        unsigned nloc = b.st[0], nx = b.st[1];
        if (nloc == 0u) { xcd_barrier_complete(bar, b.x, nloc, nx); b.st[0] = nloc; b.st[1] = nx; }
        const unsigned old = xb_add(&bar[XB_XSUB(b.x)], 1u);
        const unsigned gen = old / nloc;
        if (old + 1u == (gen + 1u) * nloc) {
            __builtin_amdgcn_fence(__ATOMIC_RELEASE, "agent");
            asm volatile("s_waitcnt vmcnt(0)" ::: "memory");
            const unsigned og = xb_add(&bar[XB_TOP], 1u);
            const unsigned tg = og / nx;
            if (og + 1u == (tg + 1u) * nx) xb_add(&bar[XB_TOPGEN], 1u);
            else XB_SPIN(xb_ld(&bar[XB_TOPGEN]) == tg, bar);
            __builtin_amdgcn_fence(__ATOMIC_ACQUIRE, "agent");
            xb_add(&bar[XB_XGEN(b.x)], 1u);
            asm volatile("s_waitcnt vmcnt(0)" ::: "memory");
        } else {
            XB_SPIN(xb_ld(&bar[XB_XGEN(b.x)]) == gen, bar);
            __builtin_amdgcn_fence(__ATOMIC_ACQUIRE, "agent");
            asm volatile("s_waitcnt vmcnt(0)" ::: "memory");
        }
    }
    __syncthreads();
}

constexpr int NWAVES = 8;
struct Frame {
    LAS unsigned char* lds;
    volatile LAS unsigned* MISC;
    gu32* ctl;
    int tid, lane, wave;
    int vcu, G;
};
namespace pg8 {
#define EPI_ROW16(v, acc, ai, m) float v[16]; _Pragma("unroll") for (int bj_ = 0; bj_ < 2; ++bj_) _Pragma("unroll") for (int n_ = 0; n_ < 2; ++n_) _Pragma("unroll") for (int j_ = 0; j_ < 4; ++j_) v[8 * bj_ + 4 * n_ + j_] = acc[ai][bj_][m][n_][j_]

struct EpiPlain {
    static constexpr bool PERM = true;
    bf16_t* O; int ldc; int pn_mask;
    __device__ __forceinline__ void operator()(const f32x4 (&acc)[2][2][4][2], const Unit& u, int wr, int wc, int fr, int fq) const {
        const int row0 = u.pm * BM + wr * 64 + fr, col0 = (u.pn & pn_mask) * BM + wc * 32 + 8 * fq;
#pragma unroll
        for (int ai = 0; ai < 2; ++ai)
#pragma unroll
            for (int m = 0; m < 4; ++m) { bf16_t* rowp = O + (size_t)(row0 + ai * HALF + m * 16) * ldc + col0;
#pragma unroll
                for (int bj = 0; bj < 2; ++bj) { const f32x4 v0 = acc[ai][bj][m][0], v1 = acc[ai][bj][m][1]; u32x4 w; w.x = cvt_pk_bf16(v0[0], v0[1]); w.y = cvt_pk_bf16(v0[2], v0[3]); w.z = cvt_pk_bf16(v1[0], v1[1]); w.w = cvt_pk_bf16(v1[2], v1[3]);
                    *(u32x4*)(rowp + bj * HALF) = w; } }
    }
};

struct Epi1 {
    static constexpr bool PERM = true;
    bf16_t *Qm, *CK, *DQ, *DK, *DV, *G; float* CKS; const float *bgate, *gq, *gk;
    __device__ __forceinline__ void operator()(const f32x4 (&acc)[2][2][4][2], const Unit& u, int wr, int wc, int fr, int fq) const {
        const int row0 = u.pm * BM + wr * 64 + fr, pn = u.pn;
        if (pn < 3) {
#pragma unroll
            for (int ai = 0; ai < 2; ++ai)
#pragma unroll
                for (int m = 0; m < 4; ++m) { EPI_ROW16(v, acc, ai, m); bf16_t* rowp = Qm + (size_t)(row0 + ai * HALF + m * 16) * LD_QM + pn * 256 + wc * 32 + 8 * fq;
                    *(u32x4*)(rowp) = pack8(v); *(u32x4*)(rowp + HALF) = pack8(v + 8); }
        } else if (pn == 3) {
#pragma unroll
            for (int ai = 0; ai < 2; ++ai)
#pragma unroll
                for (int m = 0; m < 4; ++m) { EPI_ROW16(v, acc, ai, m); const int row = row0 + ai * HALF + m * 16; bf16_t* rowp = CK + (size_t)row * LD_CK + wc * 32 + 8 * fq;
                    float s = 0.f;
#pragma unroll
                    for (int e = 0; e < 16; ++e) s += v[e] * v[e];
                    s += __shfl_xor(s, 16); s += __shfl_xor(s, 32);
                    if (fq == 0) CKS[(size_t)row * 4 + wc] = s;
                    *(u32x4*)(rowp) = pack8(v); *(u32x4*)(rowp + HALF) = pack8(v + 8); }
        } else if (pn < 16) {
            const bool isq = pn < 10; const int idx = pn - (isq ? 4 : 10), g = idx >> 1, h = 4 * (idx & 1) + wc;
            const float* gain = (isq ? gq : gk) + g * 64; const float qs = isq ? QS_DIL : 1.0f;
            float gn[16];
#pragma unroll
            for (int bj = 0; bj < 2; ++bj) { const f32x4 a = *(const f32x4*)(gain + 32 * bj + 8 * fq), b = *(const f32x4*)(gain + 32 * bj + 8 * fq + 4);
#pragma unroll
                for (int j = 0; j < 4; ++j) { gn[8 * bj + j] = a[j] * qs; gn[8 * bj + 4 + j] = b[j] * qs; } }
            bf16_t* base = (isq ? DQ : DK) + g * 512 + h * 64 + 8 * fq;
#pragma unroll
            for (int ai = 0; ai < 2; ++ai)
#pragma unroll
                for (int m = 0; m < 4; ++m) { EPI_ROW16(v, acc, ai, m); const int row = row0 + ai * HALF + m * 16;
                    float s = 0.f;
#pragma unroll
                    for (int e = 0; e < 16; ++e) s += v[e] * v[e];
                    s += __shfl_xor(s, 16); s += __shfl_xor(s, 32);
                    const float rstd = 1.0f / sqrtf(s * (1.0f / 64.0f) + EPS);
#pragma unroll
                    for (int e = 0; e < 16; ++e) v[e] = v[e] * rstd * gn[e];
                    bf16_t* rowp = base + (size_t)row * LD_DIL;
                    *(u32x4*)(rowp) = pack8(v); *(u32x4*)(rowp + 32) = pack8(v + 8); }
        } else if (pn < 22) {
            const int idx = pn - 16, g = idx >> 1, h = 4 * (idx & 1) + wc;
            bf16_t* base = DV + g * 512 + h * 64 + 8 * fq;
#pragma unroll
            for (int ai = 0; ai < 2; ++ai)
#pragma unroll
                for (int m = 0; m < 4; ++m) { EPI_ROW16(v, acc, ai, m); bf16_t* rowp = base + (size_t)(row0 + ai * HALF + m * 16) * LD_DIL;
                    *(u32x4*)(rowp) = pack8(v); *(u32x4*)(rowp + 32) = pack8(v + 8); }
        } else if (pn < 30) {
            const int c0 = (pn - 22) * 256 + wc * 32 + 8 * fq;
            float bv[16];
#pragma unroll
            for (int bj = 0; bj < 2; ++bj) { const f32x4 a = *(const f32x4*)(bgate + c0 + 128 * bj), b = *(const f32x4*)(bgate + c0 + 128 * bj + 4);
#pragma unroll
                for (int j = 0; j < 4; ++j) { bv[8 * bj + j] = a[j]; bv[8 * bj + 4 + j] = b[j]; } }
#pragma unroll
            for (int ai = 0; ai < 2; ++ai)
#pragma unroll
                for (int m = 0; m < 4; ++m) { EPI_ROW16(v, acc, ai, m); bf16_t* rowp = G + (size_t)(row0 + ai * HALF + m * 16) * LD_G + c0;
#pragma unroll
                    for (int e = 0; e < 16; ++e) v[e] = DBG_GATE_EXPR;
                    *(u32x4*)(rowp) = pack8(v); *(u32x4*)(rowp + HALF) = pack8(v + 8); }
        } else {
            if (wc == 0) {
#pragma unroll
                for (int ai = 0; ai < 2; ++ai)
#pragma unroll
                    for (int m = 0; m < 4; ++m) { EPI_ROW16(v, acc, ai, m); bf16_t* rowp = CK + (size_t)(row0 + ai * HALF + m * 16) * LD_CK + 256 + 8 * fq;
                        *(u32x4*)(rowp) = pack8(v); }
            }
        }
    }
};

struct Epi2 {
    static constexpr bool PERM = true;
    bf16_t *KM, *VM; const bf16_t* CK; const float *CKS, *gkm, *cs, *sn;
    __device__ __forceinline__ void operator()(const f32x4 (&acc)[2][2][4][2], const Unit& u, int wr, int wc, int fr, int fq) const {
        const int row0 = u.pm * BM + wr * 64 + fr, pn = u.pn;
        if (pn < 2) {
            const int h = 4 * pn + wc;
            const int own0 = 8 * fq, par0 = 8 * (fq ^ 2), ip0 = (8 * fq) & 15;
            float rstdk[8];
            {
                float gn[16];
#pragma unroll
                for (int bj = 0; bj < 2; ++bj) { const f32x4 a = *(const f32x4*)(gkm + 32 * bj + 8 * fq), b = *(const f32x4*)(gkm + 32 * bj + 8 * fq + 4);
#pragma unroll
                    for (int j = 0; j < 4; ++j) { gn[8 * bj + j] = a[j]; gn[8 * bj + 4 + j] = b[j]; } }
#pragma unroll
                for (int ai = 0; ai < 2; ++ai)
#pragma unroll
                    for (int m = 0; m < 4; ++m) { EPI_ROW16(v, acc, ai, m); const int row = row0 + ai * HALF + m * 16;
                        const f32x4 ps = *(const f32x4*)(CKS + (size_t)row * 4);
                        const float rs = 1.0f / sqrtf(((ps[0] + ps[1]) + (ps[2] + ps[3])) * (1.0f / 256.0f) + EPS);
                        float s = 0.f;
#pragma unroll
                        for (int e = 0; e < 16; ++e) { v[e] *= rs; s += v[e] * v[e]; }
                        float ko[8];
                        unpack8(*(const u32x4*)(CK + (size_t)row * LD_CK + 256 + own0), ko);
#pragma unroll
                        for (int j = 0; j < 8; ++j) s += ko[j] * ko[j];
                        s += __shfl_xor(s, 16); s += __shfl_xor(s, 32);
                        const float rstd = 1.0f / sqrtf(s * (1.0f / 96.0f) + EPS);
                        rstdk[ai * 4 + m] = rstd;
#pragma unroll
                        for (int e = 0; e < 16; ++e) v[e] = v[e] * rstd * gn[e];
                        bf16_t* rowp = KM + (size_t)row * LD_KM + h * 96;
                        *(u32x4*)(rowp + 8 * fq) = pack8(v); *(u32x4*)(rowp + 32 + 8 * fq) = pack8(v + 8);
                        asm volatile("" ::: "memory"); }
            }
            {
                float gr_own[8], gr_par[8];
#pragma unroll
                for (int j = 0; j < 8; ++j) { gr_own[j] = gkm[64 + own0 + j]; gr_par[j] = gkm[64 + par0 + j]; }
#pragma unroll
                for (int ai = 0; ai < 2; ++ai)
#pragma unroll
                    for (int m = 0; m < 4; ++m) { const int row = row0 + ai * HALF + m * 16; const float rstd = rstdk[ai * 4 + m];
                        float ko[8], kp[8];
                        unpack8(*(const u32x4*)(CK + (size_t)row * LD_CK + 256 + own0), ko); unpack8(*(const u32x4*)(CK + (size_t)row * LD_CK + 256 + par0), kp);
                        const f32x4 c0 = *(const f32x4*)(cs + (size_t)row * 16 + ip0), c1 = *(const f32x4*)(cs + (size_t)row * 16 + ip0 + 4);
                        const f32x4 n0 = *(const f32x4*)(sn + (size_t)row * 16 + ip0), n1 = *(const f32x4*)(sn + (size_t)row * 16 + ip0 + 4);
                        float ro[8];
#pragma unroll
                        for (int j = 0; j < 8; ++j) { const float c = j < 4 ? c0[j & 3] : c1[j & 3], sv = j < 4 ? n0[j & 3] : n1[j & 3];
                            const float a = ko[j] * gr_own[j], b = kp[j] * gr_par[j];
                            ro[j] = (fq < 2 ? (a * c - b * sv) : (a * c + b * sv)) * rstd; }
                        *(u32x4*)(KM + (size_t)row * LD_KM + h * 96 + 64 + own0) = pack8(ro);
                        asm volatile("" ::: "memory"); }
            }
        } else {
            const int h = 4 * (pn - 2) + wc;
#pragma unroll
            for (int ai = 0; ai < 2; ++ai)
#pragma unroll
                for (int m = 0; m < 4; ++m) { EPI_ROW16(v, acc, ai, m); const int row = row0 + ai * HALF + m * 16;
                    const f32x4 ps = *(const f32x4*)(CKS + (size_t)row * 4);
                    const float rs = 1.0f / sqrtf(((ps[0] + ps[1]) + (ps[2] + ps[3])) * (1.0f / 256.0f) + EPS);
#pragma unroll
                    for (int e = 0; e < 16; ++e) v[e] *= rs;
                    bf16_t* rowp = VM + (size_t)row * LD_VM + h * 64 + 8 * fq;
                    *(u32x4*)(rowp) = pack8(v); *(u32x4*)(rowp + 32) = pack8(v + 8); }
        }
    }
};

struct EpiMerge {
    static constexpr bool PERM = true;
    bf16_t* MG; const bf16_t *UM, *G;
    __device__ __forceinline__ void operator()(const f32x4 (&acc)[2][2][4][2], const Unit& u, int wr, int wc, int fr, int fq) const {
        const int row0 = u.pm * BM + wr * 64 + fr, col0 = u.pn * BM + wc * 32 + 8 * fq;
#pragma unroll
        for (int ai = 0; ai < 2; ++ai)
#pragma unroll
            for (int m = 0; m < 4; ++m) { const int row = row0 + ai * HALF + m * 16;
#pragma unroll
                for (int bj = 0; bj < 2; ++bj) { const int col = col0 + bj * HALF;
                    float s0[8], s1[8], um[8], o[8];
                    unpack8(*(const u32x4*)(G + (size_t)row * LD_G + col), s0); unpack8(*(const u32x4*)(G + (size_t)row * LD_G + 1024 + col), s1); unpack8(*(const u32x4*)(UM + (size_t)row * 1024 + col), um);
#pragma unroll
                    for (int j = 0; j < 8; ++j) o[j] = s1[j] * acc[ai][bj][m][j >> 2][j & 3] + s0[j] * um[j];
                    *(u32x4*)(MG + (size_t)row * 1024 + col) = pack8(o); } }
    }
};

struct EpiResid {
    static constexpr bool PERM = false;
    const float* X; float* O;
    __device__ __forceinline__ void operator()(const f32x4 (&acc)[2][2][4][2], const Unit& u, int wr, int wc, int fr, int fq) const {
        const int row0 = u.pm * BM + wr * 64 + fr, col0 = u.pn * BM + wc * 32 + 4 * fq;
#pragma unroll
        for (int ai = 0; ai < 2; ++ai)
#pragma unroll
            for (int m = 0; m < 4; ++m) { const size_t off = (size_t)(row0 + ai * HALF + m * 16) * 1024 + col0;
#pragma unroll
                for (int bj = 0; bj < 2; ++bj)
#pragma unroll
                    for (int n = 0; n < 2; ++n) *(f32x4*)(O + off + bj * HALF + n * 16) = *(const f32x4*)(X + off + bj * HALF + n * 16) + acc[ai][bj][m][n]; }
    }
};

struct EpiSwiglu {
    static constexpr bool PERM = true;
    bf16_t* HE;
    __device__ __forceinline__ void operator()(const f32x4 (&acc)[2][2][4][2], const Unit& u, int wr, int wc, int fr, int fq) const {
        const int row0 = u.pm * BM + wr * 64 + fr, col0 = (u.pn & 1) * 128 + wc * 32 + 8 * fq;
#pragma unroll
        for (int ai = 0; ai < 2; ++ai)
#pragma unroll
            for (int m = 0; m < 4; ++m) { float o[8];
#pragma unroll
                for (int j = 0; j < 8; ++j) { const float gt = acc[ai][0][m][j >> 2][j & 3], up = acc[ai][1][m][j >> 2][j & 3]; o[j] = gt * fast_sigmoid(gt) * up; }
                *(u32x4*)(HE + (size_t)(row0 + ai * HALF + m * 16) * DFF + col0) = pack8(o); }
    }
};
#undef EPI_ROW16
}
__device__ __forceinline__ void transpose_item(const float* W, int ldw, int k0, int n0, bf16_t* WT, int ldt, int dst_row0, const float* kscale, LAS float* scr, int lane) {
#pragma unroll 8
    for (int i = 0; i < 32; ++i) { const int kk = 2 * i + (lane >> 5); float v = W[(size_t)(k0 + kk) * ldw + n0 + (lane & 31)]; if (kscale) v *= kscale[k0 + kk]; scr[kk * 33 + (lane & 31)] = v; }
    LDS_WAIT(); asm volatile("" ::: "memory");
    const int c = lane & 7;
#pragma unroll
    for (int j = 0; j < 4; ++j) { const int n = (lane >> 3) + 8 * j; const LAS float* s = scr + (8 * c) * 33 + n;
        u32x4 o; o.x = cvt_pk_bf16(s[0 * 33], s[1 * 33]); o.y = cvt_pk_bf16(s[2 * 33], s[3 * 33]); o.z = cvt_pk_bf16(s[4 * 33], s[5 * 33]); o.w = cvt_pk_bf16(s[6 * 33], s[7 * 33]);
        *(GAS u32x4*)(WT + (size_t)(dst_row0 + n) * ldt + k0 + 8 * c) = o; }
    LDS_WAIT(); asm volatile("" ::: "memory");
}
__host__ __device__ __forceinline__ int win_row(int n) {
    if (n < 1024) return n;
    if (n < 1056) return 30 * 256 + (n - 1024);
    if (n < 5664) { const int mm = n - 1056, sg = mm / 512, hh = (mm % 512) / 64, d = mm % 64; const int pn = 4 + sg * 2 + (hh >> 2); return pn * 256 + (d >> 5) * 128 + (hh & 3) * 32 + (d & 31); }
    return 22 * 256 + (n - 5664);
}
__host__ __device__ __forceinline__ int wukv_row(int n) {
    const int h = n >> 7, c = n & 127, isv = c >> 6, d = c & 63; const int pn = 2 * isv + (h >> 2); return pn * 256 + (d >> 5) * 128 + (h & 3) * 32 + (d & 31);
}

struct P0Args { const float *x, *norm_attn, *w_in, *norm_ckv, *w_ukv, *w_o_mla, *w_o_dil, *w_out; const int* positions; bf16_t *WinT, *WukvT, *WoMT, *WoDT, *WoutT, *XN; float *cs, *sn; };
__device__ __forceinline__ void p0_prologue(Frame& F, const P0Args& a) {
    LAS float* scr = (LAS float*)(F.lds + RING_OFF + F.wave * 16384);
    const int gw = F.vcu * NWAVES + F.wave, NGW = F.G * NWAVES;
    constexpr int I_IN = 16 * (IN_COLS / 32), I_UKV = 4 * 32, I_OM = 8 * 32, I_OD = 8 * 32, I_OUT = 16 * 32, I_PAD = 224;
    constexpr int NITEMS = I_IN + I_UKV + I_OM + I_OD + I_OUT + I_PAD;
    for (int it = gw; it < NITEMS; it += NGW) {
        int r = it;
        if (r < I_IN) { const int nb = r % (IN_COLS / 32), kb = r / (IN_COLS / 32); transpose_item(a.w_in, IN_COLS, 64 * kb, 32 * nb, a.WinT, 1024, win_row(32 * nb), nullptr, scr, F.lane); continue; } r -= I_IN;
        if (r < I_UKV) { const int nb = r % 32, kb = r / 32; transpose_item(a.w_ukv, 1024, 64 * kb, 32 * nb, a.WukvT, 256, wukv_row(32 * nb), a.norm_ckv, scr, F.lane); continue; } r -= I_UKV;
        if (r < I_OM) { const int nb = r % 32, kb = r / 32; transpose_item(a.w_o_mla, 1024, 64 * kb, 32 * nb, a.WoMT, 512, 32 * nb, nullptr, scr, F.lane); continue; } r -= I_OM;
        if (r < I_OD) { const int nb = r % 32, kb = r / 32; transpose_item(a.w_o_dil, 1024, 64 * kb, 32 * nb, a.WoDT, 512, 32 * nb, nullptr, scr, F.lane); continue; } r -= I_OD;
        if (r < I_OUT) { const int nb = r % 32, kb = r / 32; transpose_item(a.w_out, 1024, 64 * kb, 32 * nb, a.WoutT, 1024, 32 * nb, nullptr, scr, F.lane); continue; } r -= I_OUT;
        { GAS u32x4* z = (GAS u32x4*)(a.WinT + (size_t)(30 * 256 + 32 + r) * 1024) + F.lane; z[0] = (u32x4){0u, 0u, 0u, 0u}; z[64] = (u32x4){0u, 0u, 0u, 0u}; }
    }
    f32x4 gv[4];
#pragma unroll
    for (int j = 0; j < 4; ++j) gv[j] = ((const GAS f32x4*)a.norm_attn)[F.lane + 64 * j];
    for (int m = gw; m < T_TOK; m += NGW) {
        const GAS f32x4* xr = (const GAS f32x4*)(a.x + (size_t)m * D_MODEL) + F.lane;
        f32x4 v[4]; float s = 0.f;
#pragma unroll
        for (int j = 0; j < 4; ++j) { v[j] = xr[64 * j]; s += (v[j].x * v[j].x + v[j].y * v[j].y) + (v[j].z * v[j].z + v[j].w * v[j].w); }
        const float rstd = 1.f / sqrtf(wave_sum(s) * (1.f / D_MODEL) + EPS);
        GAS u32x2* o8 = (GAS u32x2*)(a.XN + (size_t)m * D_MODEL) + F.lane;
#pragma unroll
        for (int j = 0; j < 4; ++j) { u32x2 w; w.x = cvt_pk_bf16(v[j].x * rstd * gv[j].x, v[j].y * rstd * gv[j].y); w.y = cvt_pk_bf16(v[j].z * rstd * gv[j].z, v[j].w * rstd * gv[j].w); o8[64 * j] = w; }
    }
    const int gt = F.vcu * (NWAVES * 64) + F.tid, NGT = F.G * NWAVES * 64;
    for (int idx = gt; idx < T_TOK * 16; idx += NGT) {
        const int t = idx >> 4, i = idx & 15;
        const float freq = exp2f(-(float)i * (13.287712379549449f / 16.0f));
        const float ang = (float)a.positions[t] * freq;
        float sv, cv; sincosf(ang, &sv, &cv);
        a.cs[idx] = cv; a.sn[idx] = sv;
    }
}

struct P6Args { const float *w_gate, *w_up, *w_down; bf16_t *WguT, *WdT; };
__device__ __forceinline__ void p6_weights(Frame& F, const P6Args& a) {
    LAS float* scr = (LAS float*)(F.lds + RING_OFF + F.wave * 16384);
    const int gw = F.vcu * NWAVES + F.wave, NGW = F.G * NWAVES;
    constexpr int I_G = 16 * 8, I_D = 4 * 32;
    constexpr int NITEMS = NEXP * (2 * I_G + I_D);
    for (int it = gw; it < NITEMS; it += NGW) {
        const int e = it / (2 * I_G + I_D); int r = it % (2 * I_G + I_D);
        if (r < 2 * I_G) { const int up = r / I_G; r %= I_G; const int nb = r % 8, kb = r / 8; const int j = 32 * nb;
            transpose_item((up ? a.w_up : a.w_gate) + (size_t)e * 1024 * 256, 256, 64 * kb, j, a.WguT, 1024, 512 * e + 256 * (j >> 7) + 128 * up + (j & 127), nullptr, scr, F.lane); }
        else { r -= 2 * I_G; const int nb = r % 32, kb = r / 32; transpose_item(a.w_down + (size_t)e * 256 * 1024, 1024, 64 * kb, 32 * nb, a.WdT, 256, 1024 * e + 32 * nb, nullptr, scr, F.lane); }
    }
}
namespace mla {
constexpr int NW = 8, QBLK = 32, KVBLK = 64, KPITCH = 208;
constexpr int SHM_V = KVBLK * 64 * 2, SHM_K = KVBLK * KPITCH;
constexpr int LDS_V = 0, LDS_K = 2 * SHM_V, LDS_WS = LDS_K + 2 * SHM_K, LDS_BYTES = LDS_WS + NW * 64 * 4;
constexpr float THR = 6.0f;
__device__ __forceinline__ int crow(int r, int hi) { return (r & 3) + 8 * (r >> 2) + 4 * hi; }
__device__ __forceinline__ int v_st(int k, int c) { const int kk = (k & ~0xC) | ((k & 4) << 1) | ((k & 8) >> 1); return ((kk >> 3) * 2 + (c >> 5)) * 512 + ((kk & 7) * 32 + (c & 31)) * 2; }
__device__ __forceinline__ int v_rd_base(int lane) { return ((lane & 3) << 3) | (((lane >> 2) & 3) << 6) | (((lane >> 4) & 1) << 5) | (((lane >> 5) & 1) << 8); }
constexpr int v_rd_off(int d0, int ks, int half) { return d0 * 512 + ks * 2048 + half * 1024; }
template <int OFF> __device__ __forceinline__ s16x4 tr_read(int vb) { s16x4 r; asm volatile("ds_read_b64_tr_b16 %0, %1 offset:%2" : "=&v"(r) : "v"(vb), "i"(OFF) : "memory"); return r; }
template <int D0> __device__ __forceinline__ void pv_one(f32x16& od, int vb, bf16x8 pa0, bf16x8 pa1, bf16x8 pa2, bf16x8 pa3) {
    const s16x4 l0 = tr_read<v_rd_off(D0, 0, 0)>(vb), h0 = tr_read<v_rd_off(D0, 0, 1)>(vb), l1 = tr_read<v_rd_off(D0, 1, 0)>(vb), h1 = tr_read<v_rd_off(D0, 1, 1)>(vb);
    const s16x4 l2 = tr_read<v_rd_off(D0, 2, 0)>(vb), h2 = tr_read<v_rd_off(D0, 2, 1)>(vb), l3 = tr_read<v_rd_off(D0, 3, 0)>(vb), h3 = tr_read<v_rd_off(D0, 3, 1)>(vb);
    asm volatile("s_waitcnt lgkmcnt(0)" ::: "memory"); SBAR();
#define PK(L, H) (bf16x8){L[0], L[1], L[2], L[3], H[0], H[1], H[2], H[3]}
    od = __builtin_amdgcn_mfma_f32_32x32x16_bf16(pa0, PK(l0, h0), od, 0, 0, 0);
    od = __builtin_amdgcn_mfma_f32_32x32x16_bf16(pa1, PK(l1, h1), od, 0, 0, 0);
    od = __builtin_amdgcn_mfma_f32_32x32x16_bf16(pa2, PK(l2, h2), od, 0, 0, 0);
    od = __builtin_amdgcn_mfma_f32_32x32x16_bf16(pa3, PK(l3, h3), od, 0, 0, 0);
#undef PK
}
__device__ __forceinline__ void partialSM(f32x16& p0, f32x16& p1, float& m_reg, float& alpha) {
    float pmax = p0[0];
#pragma unroll
    for (int r = 1; r < 16; ++r) pmax = fmaxf(pmax, p0[r]);
#pragma unroll
    for (int r = 0; r < 16; ++r) pmax = fmaxf(pmax, p1[r]);
    { auto rr = __builtin_amdgcn_permlane32_swap(__float_as_uint(pmax), __float_as_uint(pmax), false, false); pmax = fmaxf(__uint_as_float(rr[0]), __uint_as_float(rr[1])); }
    float mn;
    if (__builtin_expect(__all(pmax - m_reg <= THR), 1)) { mn = m_reg; alpha = 1.f; }
    else { mn = fmaxf(m_reg, pmax); alpha = __builtin_amdgcn_exp2f(m_reg - mn); m_reg = mn; }
#pragma unroll
    for (int r = 0; r < 16; ++r) { p0[r] = p0[r] - mn; p1[r] = p1[r] - mn; }
#pragma unroll
    for (int r = 0; r < 16; ++r) p0[r] = __builtin_amdgcn_exp2f(p0[r]);
}
__device__ __forceinline__ void finishSM(f32x16& p0, f32x16& p1, float alpha, float& l_reg, bf16x8& pa0, bf16x8& pa1, bf16x8& pa2, bf16x8& pa3) {
#pragma unroll
    for (int r = 0; r < 16; ++r) p1[r] = __builtin_amdgcn_exp2f(p1[r]);
    float ps = 0;
#pragma unroll
    for (int r = 0; r < 16; ++r) ps += p0[r];
#pragma unroll
    for (int r = 0; r < 16; ++r) ps += p1[r];
    { auto rr = __builtin_amdgcn_permlane32_swap(__float_as_uint(ps), __float_as_uint(ps), false, false); ps = __uint_as_float(rr[0]) + __uint_as_float(rr[1]); }
    l_reg = l_reg * alpha + ps;
#define PK4(P, BASE, OUT) do { unsigned a0 = cvt_pk_bf16(P[BASE + 0], P[BASE + 1]), a1 = cvt_pk_bf16(P[BASE + 2], P[BASE + 3]);   \
    unsigned b0 = cvt_pk_bf16(P[BASE + 4], P[BASE + 5]), b1 = cvt_pk_bf16(P[BASE + 6], P[BASE + 7]);                              \
    auto r0 = __builtin_amdgcn_permlane32_swap(a0, b0, false, false); auto r1 = __builtin_amdgcn_permlane32_swap(a1, b1, false, false); \
    u32x4 w = {r0[0], r1[0], r0[1], r1[1]}; OUT = __builtin_bit_cast(bf16x8, w); } while (0)
    PK4(p0, 0, pa0); PK4(p0, 8, pa1); PK4(p1, 0, pa2); PK4(p1, 8, pa3);
#undef PK4
}
__device__ __forceinline__ void qkt(f32x16& p0, f32x16& p1, const char* Ks, const bf16x8* qr, int r32, int hi) {
    p0 = f32x16{}; p1 = f32x16{};
#pragma unroll
    for (int d0 = 0; d0 < 6; ++d0) { const int cb = (d0 * 16 + hi * 8) * 2;
        const bf16x8 b0 = *reinterpret_cast<const bf16x8*>(Ks + r32 * KPITCH + cb);
        const bf16x8 b1 = *reinterpret_cast<const bf16x8*>(Ks + (32 + r32) * KPITCH + cb);
        p0 = __builtin_amdgcn_mfma_f32_32x32x16_bf16(b0, qr[d0], p0, 0, 0, 0);
        p1 = __builtin_amdgcn_mfma_f32_32x32x16_bf16(b1, qr[d0], p1, 0, 0, 0); }
}
__device__ __forceinline__ void cmask(f32x16& p0, f32x16& p1, int jb, int qrel, int hi) {
    const float NEG = -INFINITY; int lim = qrel - 64 * jb - 4 * hi; asm volatile("" : "+v"(lim));
#pragma unroll
    for (int r = 0; r < 16; ++r) { const int kv = (r & 3) + 8 * (r >> 2); if (kv > lim) p0[r] = NEG; if (kv + 32 > lim) p1[r] = NEG; }
}

__device__ __forceinline__ void mla_unit(int b, int h, int qb, bf16_t* Qm, const bf16_t* __restrict__ KM, const bf16_t* __restrict__ VM, const float* __restrict__ cs, const float* __restrict__ sn,
                                         const float* __restrict__ gq, char* lds) {
    const int tid = threadIdx.x, wid = tid >> 6, lane = tid & 63, r32 = lane & 31, hi = lane >> 5;
    char* V_lds = lds + LDS_V; char* K_lds = lds + LDS_K;
    float* ws = (float*)(lds + LDS_WS) + wid * 64; float* li_l = ws; float* al_l = ws + 32;
    const long rowbase = (long)b * SEQ; const int q0 = qb * 256;
    const bf16_t* Kh = KM + rowbase * LD_KM + h * 96; const bf16_t* Vh = VM + rowbase * LD_VM + h * 64;
    float m_reg = -1e30f, l_reg = 0; f32x16 o[2] = {}; bf16x8 qr[6];
    {
        const long trow = rowbase + q0 + wid * QBLK + r32;
        const bf16_t* qp = Qm + trow * LD_QM + h * 96 + hi * 8;
        float qf[6][8]; float ss = 0.f;
#pragma unroll
        for (int d0 = 0; d0 < 6; ++d0) { unpack8(*(const u32x4*)(qp + d0 * 16), qf[d0]);
#pragma unroll
            for (int j = 0; j < 8; ++j) ss += qf[d0][j] * qf[d0][j]; }
        ss += __shfl_xor(ss, 32);
        const float sc = QS_MLA / sqrtf(ss * (1.0f / 96.0f) + EPS);
#pragma unroll
        for (int d0 = 0; d0 < 6; ++d0)
#pragma unroll
            for (int j = 0; j < 8; ++j) qf[d0][j] *= sc * gq[d0 * 16 + hi * 8 + j];
#pragma unroll
        for (int j = 0; j < 8; ++j) { const float c = cs[trow * 16 + hi * 8 + j], s = sn[trow * 16 + hi * 8 + j]; const float t1 = qf[4][j], t2 = qf[5][j];
            qf[4][j] = t1 * c - t2 * s; qf[5][j] = t2 * c + t1 * s; }
#pragma unroll
        for (int d0 = 0; d0 < 6; ++d0) qr[d0] = __builtin_bit_cast(bf16x8, pack8(qf[d0]));
    }
    const int sr = tid >> 3, sc8 = (tid & 7) * 8, sr2 = (tid >> 2) & 63, sc2 = 64 + (tid & 3) * 8;
    const int vst = v_st(sr, sc8);
    const int vb0 = (int)(uintptr_t)V_lds + v_rd_base(lane);
    const bool two = wid < 4;
    bf16x8 st_v0, st_k0, st_k1 = {};
#define SLOAD(kk0) do { st_v0 = *(const bf16x8*)(Vh + (long)((kk0) + sr) * LD_VM + sc8); st_k0 = *(const bf16x8*)(Kh + (long)((kk0) + sr) * LD_KM + sc8); \
    if (two) st_k1 = *(const bf16x8*)(Kh + (long)((kk0) + sr2) * LD_KM + sc2); } while (0)
#define SWRITE(bb) do { *(bf16x8*)(V_lds + (bb) * SHM_V + vst) = st_v0; *(bf16x8*)(K_lds + (bb) * SHM_K + sr * KPITCH + sc8 * 2) = st_k0; \
    if (two) *(bf16x8*)(K_lds + (bb) * SHM_K + sr2 * KPITCH + sc2 * 2) = st_k1; } while (0)
#define RESC(a) do { if (__any((a) < 1.f)) { if (hi == 0) al_l[r32] = (a); asm volatile("s_waitcnt lgkmcnt(0)" ::: "memory"); \
    _Pragma("unroll") for (int d = 0; d < 2; ++d) _Pragma("unroll") for (int r = 0; r < 16; ++r) o[d][r] *= al_l[crow(r, hi)]; } } while (0)
    f32x16 pA0, pA1, pB0, pB1; float alA, alB; bf16x8 pa0, pa1, pa2, pa3;
    const int NT = 4 * (qb + 1);
    const int qrel = wid * QBLK + r32;
#define CMASK(P0, P1, t) do { const int jb_ = (t) - (NT - 4); if (jb_ >= 0) cmask(P0, P1, jb_, qrel, hi); } while (0)
    __syncthreads();
    SLOAD(0); SWRITE(0); __syncthreads();
    qkt(pA0, pA1, K_lds, qr, r32, hi); CMASK(pA0, pA1, 0); partialSM(pA0, pA1, m_reg, alA);
    SLOAD(KVBLK); SWRITE(1); __syncthreads();
#pragma unroll 1
    for (int j = 1; j + 1 < NT; j += 2) {
        SBAR(); qkt(pB0, pB1, K_lds + SHM_K, qr, r32, hi); CMASK(pB0, pB1, j);
        finishSM(pA0, pA1, alA, l_reg, pa0, pa1, pa2, pa3); SBAR();
        SLOAD((j + 1) * KVBLK); SBAR();
        pv_one<0>(o[0], vb0, pa0, pa1, pa2, pa3); pv_one<1>(o[1], vb0, pa0, pa1, pa2, pa3); partialSM(pB0, pB1, m_reg, alB);
        __syncthreads(); SWRITE(0);
        RESC(alB); __syncthreads();
        SBAR(); qkt(pA0, pA1, K_lds, qr, r32, hi); CMASK(pA0, pA1, j + 1);
        finishSM(pB0, pB1, alB, l_reg, pa0, pa1, pa2, pa3); SBAR();
        SLOAD((j + 2) * KVBLK); SBAR();
        pv_one<0>(o[0], vb0 + SHM_V, pa0, pa1, pa2, pa3); pv_one<1>(o[1], vb0 + SHM_V, pa0, pa1, pa2, pa3); partialSM(pA0, pA1, m_reg, alA);
        __syncthreads(); SWRITE(1);
        RESC(alA); __syncthreads();
    }
    SBAR(); qkt(pB0, pB1, K_lds + SHM_K, qr, r32, hi); CMASK(pB0, pB1, NT - 1);
    finishSM(pA0, pA1, alA, l_reg, pa0, pa1, pa2, pa3); SBAR();
    pv_one<0>(o[0], vb0, pa0, pa1, pa2, pa3); pv_one<1>(o[1], vb0, pa0, pa1, pa2, pa3); partialSM(pB0, pB1, m_reg, alB);
    RESC(alB);
    finishSM(pB0, pB1, alB, l_reg, pa0, pa1, pa2, pa3); SBAR();
    pv_one<0>(o[0], vb0 + SHM_V, pa0, pa1, pa2, pa3); pv_one<1>(o[1], vb0 + SHM_V, pa0, pa1, pa2, pa3);
    if (hi == 0) li_l[r32] = l_reg; asm volatile("s_waitcnt lgkmcnt(0)" ::: "memory");
    bf16_t* Ow = Qm + (rowbase + q0 + wid * QBLK) * LD_QM + h * 96;
#pragma unroll
    for (int r = 0; r < 16; ++r) { const int orow = crow(r, hi); const float rl = __builtin_amdgcn_rcpf(li_l[orow]);
#pragma unroll
        for (int d0 = 0; d0 < 2; ++d0) { const unsigned w = cvt_pk_bf16(o[d0][r] * rl, 0.f); Ow[(long)orow * LD_QM + d0 * 32 + r32] = (bf16_t)(w & 0xffffu); } }
#undef SLOAD
#undef SWRITE
#undef RESC
#undef CMASK
}
}
namespace dil {
using mla::crow; using mla::v_st; using mla::v_rd_base; using mla::v_rd_off; using mla::tr_read;
constexpr int LDS_O = 0, LDS_M = 65536, LDS_L = 66560, LDS_VW = 67584, LDS_SW = LDS_VW + 8 * 4096, LDS_BYTES = LDS_SW + 8 * 512;
template <int G> __device__ __forceinline__ int tq_of(int wid, int q, int c8) {
    if constexpr (G == 0) return 256 * c8 + 32 * wid + q;
    else if constexpr (G == 1) return 4 * (64 * c8 + 32 * (wid >> 2) + q) + (wid & 3);
    else return 16 * (16 * c8 + (q & 15)) + 2 * wid + (q >> 4);
}
template <int G> __device__ __forceinline__ int tk_of(int wid, int kk, int kt, int c8) {
    if constexpr (G == 0) return 256 * c8 + 32 * wid - 128 + 32 * kt + kk;
    else if constexpr (G == 1) return 4 * (64 * c8 + 32 * (wid >> 2) - 128 + 32 * kt + kk) + (wid & 3);
    else return 16 * (16 * kt + (kk & 15)) + 2 * wid + (kk >> 4);
}
template <int G> __device__ __forceinline__ int ti_of(int wid, int q) {
    if constexpr (G == 0) return 32 * wid + q;
    else if constexpr (G == 1) return 128 * (wid >> 2) + 4 * q + (wid & 3);
    else return 16 * (q & 15) + 2 * wid + (q >> 4);
}
#define DIL_PK4(P, BASE, OUT) do { unsigned a0 = cvt_pk_bf16(P[BASE + 0], P[BASE + 1]), a1 = cvt_pk_bf16(P[BASE + 2], P[BASE + 3]);   \
    unsigned b0 = cvt_pk_bf16(P[BASE + 4], P[BASE + 5]), b1 = cvt_pk_bf16(P[BASE + 6], P[BASE + 7]);                              \
    auto r0 = __builtin_amdgcn_permlane32_swap(a0, b0, false, false); auto r1 = __builtin_amdgcn_permlane32_swap(a1, b1, false, false); \
    u32x4 w = {r0[0], r1[0], r0[1], r1[1]}; OUT = __builtin_bit_cast(bf16x8, w); } while (0)

template <int G> __device__ __forceinline__ void dil_pass(int b, int h, int c8, bf16_t* DQ, const bf16_t* __restrict__ DK, const bf16_t* __restrict__ DV, char* lds, float slope2) {
    constexpr int DIL = (G == 0) ? 1 : (G == 1) ? 4 : 16, DMAX = 128 * DIL;
    const int tid = threadIdx.x, wid = tid >> 6, lane = tid & 63, r32 = lane & 31, hi = lane >> 5;
    float* OST = (float*)(lds + LDS_O); float* MST = (float*)(lds + LDS_M); float* LST = (float*)(lds + LDS_L);
    char* Vw = lds + LDS_VW + wid * 4096; float* sw = (float*)(lds + LDS_SW + wid * 512);
    const int vb = (int)(uintptr_t)Vw + v_rd_base(lane);
    const long seqbase = (long)b * SEQ;
    const int tq = tq_of<G>(wid, r32, c8);
    bf16x8 qr[4];
    { const bf16_t* qp = DQ + (seqbase + tq) * LD_DIL + G * 512 + h * 64 + hi * 8;
#pragma unroll
      for (int d0 = 0; d0 < 4; ++d0) qr[d0] = *(const bf16x8*)(qp + 16 * d0); }
    float m = -1e30f, l = 0.f; f32x16 o[2] = {};
    const int nkt = (G < 2) ? 5 : c8 + 1;
    const int vkey = lane >> 1, vcol = 32 * (lane & 1);
    for (int kt = 0; kt < nkt; ++kt) {
        if (G < 2) { if (tk_of<G>(wid, 31, kt, c8) < 0) continue; }
        const int tkc = max(tk_of<G>(wid, r32, kt, c8), 0);
        const bf16_t* kp = DK + (seqbase + tkc) * LD_DIL + G * 512 + h * 64 + hi * 8;
        bf16x8 kf[4];
#pragma unroll
        for (int d0 = 0; d0 < 4; ++d0) kf[d0] = *(const bf16x8*)(kp + 16 * d0);
        const int tkv = max(tk_of<G>(wid, vkey, kt, c8), 0);
        const bf16_t* vp = DV + (seqbase + tkv) * LD_DIL + G * 512 + h * 64 + vcol;
        bf16x8 vv[4];
#pragma unroll
        for (int i = 0; i < 4; ++i) vv[i] = *(const bf16x8*)(vp + 8 * i);
        f32x16 p = {};
#pragma unroll
        for (int d0 = 0; d0 < 4; ++d0) p = __builtin_amdgcn_mfma_f32_32x32x16_bf16(kf[d0], qr[d0], p, 0, 0, 0);
        float pmax = -INFINITY;
#pragma unroll
        for (int r = 0; r < 16; ++r) { const int tkr = tk_of<G>(wid, crow(r, hi), kt, c8), delta = tq - tkr;
            const bool ok = (tkr >= 0) && (delta >= 0) && (delta <= DMAX) && ((delta & (DIL - 1)) == 0);
            p[r] = ok ? p[r] - slope2 * (float)delta : -INFINITY; pmax = fmaxf(pmax, p[r]); }
        { auto rr = __builtin_amdgcn_permlane32_swap(__float_as_uint(pmax), __float_as_uint(pmax), false, false); pmax = fmaxf(__uint_as_float(rr[0]), __uint_as_float(rr[1])); }
        const float mn = fmaxf(m, pmax), alpha = __builtin_amdgcn_exp2f(m - mn); m = mn;
        float ps = 0.f;
#pragma unroll
        for (int r = 0; r < 16; ++r) { p[r] = __builtin_amdgcn_exp2f(p[r] - mn); ps += p[r]; }
        { auto rr = __builtin_amdgcn_permlane32_swap(__float_as_uint(ps), __float_as_uint(ps), false, false); ps = __uint_as_float(rr[0]) + __uint_as_float(rr[1]); }
        l = l * alpha + ps;
        if (__any(alpha < 1.f)) { if (hi == 0) sw[r32] = alpha; LDS_WAIT();
#pragma unroll
            for (int d = 0; d < 2; ++d)
#pragma unroll
                for (int r = 0; r < 16; ++r) o[d][r] *= sw[crow(r, hi)]; }
        bf16x8 pa0, pa1; DIL_PK4(p, 0, pa0); DIL_PK4(p, 8, pa1);
#pragma unroll
        for (int i = 0; i < 4; ++i) *(bf16x8*)(Vw + v_st(vkey, vcol + 8 * i)) = vv[i];
        LDS_WAIT();
        {
            const s16x4 l00 = tr_read<v_rd_off(0, 0, 0)>(vb), h00 = tr_read<v_rd_off(0, 0, 1)>(vb), l01 = tr_read<v_rd_off(0, 1, 0)>(vb), h01 = tr_read<v_rd_off(0, 1, 1)>(vb);
            const s16x4 l10 = tr_read<v_rd_off(1, 0, 0)>(vb), h10 = tr_read<v_rd_off(1, 0, 1)>(vb), l11 = tr_read<v_rd_off(1, 1, 0)>(vb), h11 = tr_read<v_rd_off(1, 1, 1)>(vb);
            asm volatile("s_waitcnt lgkmcnt(0)" ::: "memory"); SBAR();
#define PK(L, H) (bf16x8){L[0], L[1], L[2], L[3], H[0], H[1], H[2], H[3]}
            o[0] = __builtin_amdgcn_mfma_f32_32x32x16_bf16(pa0, PK(l00, h00), o[0], 0, 0, 0);
            o[0] = __builtin_amdgcn_mfma_f32_32x32x16_bf16(pa1, PK(l01, h01), o[0], 0, 0, 0);
            o[1] = __builtin_amdgcn_mfma_f32_32x32x16_bf16(pa0, PK(l10, h10), o[1], 0, 0, 0);
            o[1] = __builtin_amdgcn_mfma_f32_32x32x16_bf16(pa1, PK(l11, h11), o[1], 0, 0, 0);
#undef PK
        }
    }
    const int ti = ti_of<G>(wid, r32);
    if constexpr (G == 0) {
        if (hi == 0) { MST[ti] = m; LST[ti] = l; }
#pragma unroll
        for (int r = 0; r < 16; ++r) { const int tr_ = ti_of<G>(wid, crow(r, hi));
#pragma unroll
            for (int d0 = 0; d0 < 2; ++d0) OST[tr_ * 64 + 32 * d0 + r32] = o[d0][r]; }
    } else {
        if (hi == 0) { const float Mo = MST[ti], Lo = LST[ti]; const float mnew = fmaxf(Mo, m); const float a = __builtin_amdgcn_exp2f(Mo - mnew), bb = __builtin_amdgcn_exp2f(m - mnew); const float Ln = a * Lo + bb * l;
            MST[ti] = mnew; LST[ti] = Ln; sw[r32] = a; sw[32 + r32] = bb; sw[64 + r32] = 1.0f / Ln; }
        LDS_WAIT();
        bf16_t* Ob = DQ + (seqbase + 256 * c8) * LD_DIL + h * 64;
#pragma unroll
        for (int r = 0; r < 16; ++r) { const int qq = crow(r, hi), tr_ = ti_of<G>(wid, qq); const float a_r = sw[qq], b_r = sw[32 + qq], inv = sw[64 + qq];
#pragma unroll
            for (int d0 = 0; d0 < 2; ++d0) { const int idx = tr_ * 64 + 32 * d0 + r32; const float val = a_r * OST[idx] + b_r * o[d0][r];
                if constexpr (G == 2) { const unsigned w = cvt_pk_bf16(val * inv, 0.f); Ob[(long)tr_ * LD_DIL + 32 * d0 + r32] = (bf16_t)(w & 0xffffu); }
                else OST[idx] = val; } }
    }
}
__device__ __forceinline__ void dil_unit(int b, int h, int c8, bf16_t* DQ, const bf16_t* DK, const bf16_t* DV, char* lds) {
    const float slope2 = exp2f(-(float)(h + 1)) * LOG2E;
    __syncthreads();
    dil_pass<0>(b, h, c8, DQ, DK, DV, lds, slope2);
    __syncthreads();
    dil_pass<1>(b, h, c8, DQ, DK, DV, lds, slope2);
    __syncthreads();
    dil_pass<2>(b, h, c8, DQ, DK, DV, lds, slope2);
}
#undef DIL_PK4
}
struct P6bArgs { const float *x1, *norm_ffn, *w_rg, *b_rg, *w_re, *b_re; bf16_t* H2; unsigned* tinfo; int* list; gu32* cnt; };
__device__ __forceinline__ void p6_route(Frame& F, const P6bArgs& a) {
    LAS float* Wr = (LAS float*)(F.lds);
    volatile LAS unsigned* lcnt = F.MISC + 16;
    for (int idx = F.tid; idx < 1024 * 36; idx += NWAVES * 64) { const int k = idx / 36, c = idx - k * 36; Wr[idx] = c < 32 ? a.w_re[k * 32 + c] : a.w_rg[k * 4 + (c - 32)]; }
    if (F.tid < 32) lcnt[F.tid] = 0u;
    __syncthreads();
    const int gw = F.vcu * NWAVES + F.wave, NGW = F.G * NWAVES, lane = F.lane;
    float gf[16];
#pragma unroll
    for (int i = 0; i < 16; ++i) gf[i] = a.norm_ffn[lane + 64 * i];
    int s_t = -1, s_e0 = 0, s_e1 = 0; float s_w0 = 0.f, s_w1 = 0.f;
    int it = 0;
    for (int t = gw; t < T_TOK; t += NGW, ++it) {
        const float* xr = a.x1 + (size_t)t * D_MODEL + lane;
        float hx[16]; float ss = 0.f;
#pragma unroll
        for (int i = 0; i < 16; ++i) { hx[i] = xr[64 * i]; ss += hx[i] * hx[i]; }
        const float rstd = 1.f / sqrtf(wave_sum(ss) * (1.f / D_MODEL) + EPS);
        bf16_t* hp = a.H2 + (size_t)t * D_MODEL + lane;
#pragma unroll
        for (int i = 0; i < 16; ++i) { hx[i] = hx[i] * rstd * gf[i]; hp[64 * i] = (bf16_t)(cvt_pk_bf16(hx[i], 0.f) & 0xffffu); }
        float lg[4] = {0.f, 0.f, 0.f, 0.f};
#pragma unroll
        for (int i = 0; i < 16; ++i) { const f32x4 w = *(const LAS f32x4*)(Wr + (lane + 64 * i) * 36 + 32); lg[0] += hx[i] * w[0]; lg[1] += hx[i] * w[1]; lg[2] += hx[i] * w[2]; lg[3] += hx[i] * w[3]; }
#pragma unroll
        for (int c = 0; c < 4; ++c) lg[c] = wave_sum(lg[c]) + a.b_rg[c];
        int gi = 0; float gm = lg[0];
#pragma unroll
        for (int c = 1; c < 4; ++c) if (lg[c] > gm) { gm = lg[c]; gi = c; }
        float gden = 0.f;
#pragma unroll
        for (int c = 0; c < 4; ++c) gden += __expf(lg[c] - gm);
        const float g_p = 1.0f / gden;
        float le[8] = {0.f, 0.f, 0.f, 0.f, 0.f, 0.f, 0.f, 0.f};
#pragma unroll
        for (int i = 0; i < 16; ++i) { const LAS float* wp = Wr + (lane + 64 * i) * 36 + 8 * gi; const f32x4 w0 = *(const LAS f32x4*)wp, w1 = *(const LAS f32x4*)(wp + 4);
#pragma unroll
            for (int j = 0; j < 4; ++j) { le[j] += hx[i] * w0[j]; le[4 + j] += hx[i] * w1[j]; } }
#pragma unroll
        for (int j = 0; j < 8; ++j) le[j] = wave_sum(le[j]) + a.b_re[8 * gi + j];
        int e0 = 0; float m0 = le[0];
#pragma unroll
        for (int j = 1; j < 8; ++j) if (le[j] > m0) { m0 = le[j]; e0 = j; }
        int e1 = -1; float m1 = -INFINITY;
#pragma unroll
        for (int j = 0; j < 8; ++j) if (j != e0 && le[j] > m1) { m1 = le[j]; e1 = j; }
        const float p1 = __expf(m1 - m0);
        const float w0 = g_p / (1.0f + p1), w1 = g_p * p1 / (1.0f + p1);
        if (lane == it) { s_t = t; s_e0 = 8 * gi + e0; s_e1 = 8 * gi + e1; s_w0 = w0; s_w1 = w1; }
    }
    unsigned lp0 = 0u, lp1 = 0u;
    if (s_t >= 0) { lp0 = __hip_atomic_fetch_add((LAS unsigned*)&lcnt[s_e0], 1u, __ATOMIC_RELAXED, __HIP_MEMORY_SCOPE_WORKGROUP); lp1 = __hip_atomic_fetch_add((LAS unsigned*)&lcnt[s_e1], 1u, __ATOMIC_RELAXED, __HIP_MEMORY_SCOPE_WORKGROUP); }
    __syncthreads();
    if (F.tid < 32) { const unsigned c = lcnt[F.tid]; const unsigned base = c ? __hip_atomic_fetch_add(a.cnt + 64 * F.tid, c, RLX_AGENT) : 0u; lcnt[F.tid] = base; }
    __syncthreads();
    if (s_t >= 0) {
        const unsigned p0 = lcnt[s_e0] + lp0, p1 = lcnt[s_e1] + lp1;
        a.list[(size_t)s_e0 * LIST_CAP + p0] = s_t; a.list[(size_t)s_e1 * LIST_CAP + p1] = s_t;
        u32x4 ti; ti.x = ((unsigned)s_e0 << 16) | p0; ti.y = ((unsigned)s_e1 << 16) | p1; ti.z = __float_as_uint(s_w0); ti.w = __float_as_uint(s_w1);
        *(u32x4*)(a.tinfo + (size_t)s_t * 4) = ti;
    }
}

struct MoeSched {
    const LAS int* tstart;
    const LAS int* cntl;
    const int* list;
    int nct, G, c, lda_bytes;
    __device__ __forceinline__ bool next(int i, pg8::Unit& u) const {
        const int L = i * G + c, total = tstart[32] * nct; if (L >= total) return false;
        const int rt = L / nct, pnl = L - rt * nct; int e = 0;
        for (int j = 1; j < 32; ++j) e = (tstart[j] <= rt) ? j : e;
        u.pm = rt; u.pn = e * nct + pnl; u.aux = e; return true;
    }
    __device__ __forceinline__ unsigned row_off(const pg8::Unit& u, int row) const {
        const int e = u.aux, pos = (u.pm - tstart[e]) * 256 + row; const int tok = list[(size_t)e * LIST_CAP + (pos < cntl[e] ? pos : 0)];
        return (unsigned)tok * (unsigned)lda_bytes;
    }
};
__device__ __forceinline__ void moe_tables(Frame& F, const gu32* cnt) {
    LAS int* tstart = (LAS int*)(F.lds + TAB_OFF); LAS int* cntl = tstart + 64;
    __syncthreads();
    if (F.tid == 0) { int acc = 0; for (int e = 0; e < 32; ++e) { const int c = (int)__hip_atomic_load(cnt + 64 * e, RLX_AGENT); cntl[e] = c; tstart[e] = acc; acc += (c + 255) >> 8; } tstart[32] = acc; }
    __syncthreads();
}

__device__ __forceinline__ void p9_combine(Frame& F, float* out, const bf16_t* Y, const unsigned* tinfo) {
    const LAS int* tstart = (const LAS int*)(F.lds + TAB_OFF);
    const int gw = F.vcu * NWAVES + F.wave, NGW = F.G * NWAVES;
    for (int t = gw; t < T_TOK; t += NGW) {
        const u32x4 ti = *(const u32x4*)(tinfo + (size_t)t * 4);
        const int e0 = ti.x >> 16, e1 = ti.y >> 16; const size_t s0 = (size_t)tstart[e0] * 256 + (ti.x & 0xffffu), s1 = (size_t)tstart[e1] * 256 + (ti.y & 0xffffu);
        const float w0 = __uint_as_float(ti.z), w1 = __uint_as_float(ti.w);
        GAS f32x4* xr = (GAS f32x4*)(out + (size_t)t * D_MODEL) + F.lane;
        const GAS u32x2* y0 = (const GAS u32x2*)(Y + s0 * D_MODEL) + F.lane; const GAS u32x2* y1 = (const GAS u32x2*)(Y + s1 * D_MODEL) + F.lane;
#pragma unroll
        for (int j = 0; j < 4; ++j) { f32x4 v = xr[64 * j]; const u32x2 a = y0[64 * j], b = y1[64 * j];
            v.x += w0 * bflo(a.x) + w1 * bflo(b.x); v.y += w0 * bfhi(a.x) + w1 * bfhi(b.x); v.z += w0 * bflo(a.y) + w1 * bflo(b.y); v.w += w0 * bfhi(a.y) + w1 * bfhi(b.y);
            xr[64 * j] = v; }
    }
}
#ifndef MK_N_LAUNCHES
#define MK_N_LAUNCHES 1
#endif
constexpr int N_LAUNCHES = MK_N_LAUNCHES;
constexpr int NPHASE = 11;
struct Args { const float* in[22]; const int* positions; float* out; unsigned char* ws; int ph_lo, ph_hi, li, pad; };

__global__ void __launch_bounds__(NWAVES * 64, 2) fwd_kernel(Args args) {
    extern __shared__ __attribute__((aligned(16))) unsigned char lds[];
    Frame F;
    F.lds = (LAS unsigned char*)lds;
    F.MISC = (volatile LAS unsigned*)(F.lds + MISC_OFF);
    F.tid = threadIdx.x; F.lane = F.tid & 63; F.wave = __builtin_amdgcn_readfirstlane(F.tid >> 6);
    F.G = gridDim.x; { const int bx = blockIdx.x; F.vcu = (F.G % 8 == 0) ? (bx % 8) * (F.G / 8) + bx / 8 : bx; }
    F.ctl = (gu32*)(args.ws + WS_CTL);
    for (int u = F.tid; u < (LDS_BYTES - LDSCTL_OFF) / 4; u += NWAVES * 64) ((LAS unsigned*)(F.lds + LDSCTL_OFF))[u] = 0u;
    __syncthreads();
    XcdBarrier bar; bar.bar = (unsigned*)(F.ctl + CW_BAR); bar.x = 0; bar.st = nullptr;
    if (N_LAUNCHES == 1) bar = xcd_barrier_post((unsigned*)(F.ctl + CW_BAR), F.MISC + 8);
#define GRID_BAR() do { if (N_LAUNCHES == 1) xcd_barrier(bar); } while (0)
    const int lo = args.ph_lo, hi = args.ph_hi;
#ifndef PHASE_MASK
#define PHASE_MASK 0x7ff
#endif
#define IN(k) ((((PHASE_MASK) >> (k)) & 1) && lo <= (k) && (k) < hi)
#define INP(i) (args.in[i])
#define WSP(T, off) ((T*)(args.ws + (off)))
    if (IN(0)) { P0Args a{INP(0), INP(2), INP(3), INP(5), INP(6), INP(11), INP(12), INP(13), args.positions, WSP(bf16_t, WS_WIN), WSP(bf16_t, WS_WUKV), WSP(bf16_t, WS_WOM), WSP(bf16_t, WS_WOD), WSP(bf16_t, WS_WOUT), WSP(bf16_t, WS_B), WSP(float, WS_ROPE), WSP(float, WS_ROPE) + (size_t)T_TOK * 16}; p0_prologue(F, a); GRID_BAR(); }
    if (IN(1)) {
        pg8::Gemm g{WSP(bf16_t, WS_B), WSP(bf16_t, WS_WIN), 1024, 1024, 1024, 128}; pg8::StaticOrder S; S.init(T_TOK, N1_PAD, F.G, (int)blockIdx.x);
        #ifdef DBG_GATES_IN_WS
        pg8::Epi1 E{WSP(bf16_t, WS_QM), WSP(bf16_t, WS_CK), WSP(bf16_t, WS_DQ), WSP(bf16_t, WS_DQ), WSP(bf16_t, WS_DQ), WSP(bf16_t, WS_DK),
#else
        pg8::Epi1 E{WSP(bf16_t, WS_QM), WSP(bf16_t, WS_CK), WSP(bf16_t, WS_DQ), WSP(bf16_t, WS_DK), WSP(bf16_t, WS_DV), (bf16_t*)args.out,
#endif
 WSP(float, WS_CKS), INP(4), INP(9), INP(10)};
        pg8::gemm_phase<pg8::Epi1, pg8::StaticOrder, true, false>(F.lds + RING_OFF, g, S, E);
        GRID_BAR();
    }
    if (IN(2)) {
        pg8::Gemm g{WSP(bf16_t, WS_CK), WSP(bf16_t, WS_WUKV), LD_CK, 256, 256, 128}; pg8::StaticOrder S; S.init(T_TOK, 1024, F.G, (int)blockIdx.x);
        pg8::Epi2 E{WSP(bf16_t, WS_B), WSP(bf16_t, WS_VM), WSP(bf16_t, WS_CK), WSP(float, WS_CKS), INP(8), WSP(float, WS_ROPE), WSP(float, WS_ROPE) + (size_t)T_TOK * 16};
        pg8::gemm_phase<pg8::Epi2, pg8::StaticOrder, true, false>(F.lds + RING_OFF, g, S, E);
        GRID_BAR();
    }
    if (IN(3)) {
        const bool bal = (F.G == 256);
#ifndef NO_MLA
#pragma unroll 1
        for (int i = 0; ; ++i) {
            int b, h, qb;
            if (bal) { if (i >= 4) break; const int bh = F.vcu >> 1, p = F.vcu & 1; b = bh >> 3; h = bh & 7; qb = (i == 0) ? p : (i == 1) ? 7 - p : (i == 2) ? 2 + p : 5 - p; }
            else { const int L = F.vcu + i * F.G; if (L >= 1024) break; const int bh = L >> 3; b = bh >> 3; h = bh & 7; qb = L & 7; }
            mla::mla_unit(b, h, qb, WSP(bf16_t, WS_QM), WSP(bf16_t, WS_B), WSP(bf16_t, WS_VM), WSP(float, WS_ROPE), WSP(float, WS_ROPE) + (size_t)T_TOK * 16, INP(7), (char*)lds + RING_OFF);
        }
#endif
#ifndef NO_DIL
#pragma unroll 1
        for (int i = 0; ; ++i) {
            int b, h, c8;
            if (bal) { if (i >= 4) break; const int bh = F.vcu >> 1, p = F.vcu & 1; b = bh >> 3; h = bh & 7; c8 = p ? ((i == 0) ? 1 : (i == 1) ? 2 : (i == 2) ? 5 : 6) : ((i == 0) ? 0 : (i == 1) ? 3 : (i == 2) ? 4 : 7); }
            else { const int L = F.vcu + i * F.G; if (L >= 1024) break; const int bh = L >> 3; b = bh >> 3; h = bh & 7; c8 = L & 7; }
            dil::dil_unit(b, h, c8, WSP(bf16_t, WS_DQ), WSP(bf16_t, WS_DK), WSP(bf16_t, WS_DV), (char*)lds + RING_OFF);
        }
#endif
        __syncthreads();
        GRID_BAR();
    }
    if (IN(4)) {
        pg8::Gemm g{WSP(bf16_t, WS_QM), WSP(bf16_t, WS_WOM), LD_QM, 512, 512, 192}; pg8::StaticOrder S; S.init(T_TOK, 1024, F.G, (int)blockIdx.x);
        pg8::EpiPlain E{WSP(bf16_t, WS_B), 1024, 0xffff};
        pg8::gemm_phase<pg8::EpiPlain, pg8::StaticOrder, true, false>(F.lds + RING_OFF, g, S, E);
        GRID_BAR();
    }
    if (IN(5)) {
        pg8::Gemm g{WSP(bf16_t, WS_DQ), WSP(bf16_t, WS_WOD), LD_DIL, 512, 512, 128}; pg8::StaticOrder S; S.init(T_TOK, 1024, F.G, (int)blockIdx.x);
        pg8::EpiMerge E{WSP(bf16_t, WS_DV), WSP(bf16_t, WS_B), (const bf16_t*)args.out};
        pg8::gemm_phase<pg8::EpiMerge, pg8::StaticOrder, true, false>(F.lds + RING_OFF, g, S, E);
        GRID_BAR();
    }
    if (IN(6)) {
        pg8::Gemm g{WSP(bf16_t, WS_DV), WSP(bf16_t, WS_WOUT), 1024, 1024, 1024, 128}; pg8::StaticOrder S; S.init(T_TOK, 1024, F.G, (int)blockIdx.x);
        pg8::EpiResid E{INP(0), args.out};
        pg8::gemm_phase<pg8::EpiResid, pg8::StaticOrder, true, false>(F.lds + RING_OFF, g, S, E);
        GRID_BAR();
    }
    if (IN(7)) {
        P6Args wa{INP(19), INP(20), INP(21), WSP(bf16_t, WS_VM), WSP(bf16_t, WS_CK)}; p6_weights(F, wa);
        __syncthreads();
        P6bArgs ra{args.out, INP(14), INP(15), INP(16), INP(17), INP(18), WSP(bf16_t, WS_B), WSP(unsigned, WS_TINFO), WSP(int, WS_LIST), F.ctl + CW_CNT}; p6_route(F, ra);
        __syncthreads();
        GRID_BAR();
    }
    if (IN(8)) {
        moe_tables(F, F.ctl + CW_CNT);
        MoeSched S{(const LAS int*)(F.lds + TAB_OFF), (const LAS int*)(F.lds + TAB_OFF) + 64, WSP(int, WS_LIST), 2, F.G, (int)blockIdx.x, 2048};
        pg8::Gemm g{WSP(bf16_t, WS_B), WSP(bf16_t, WS_VM), 1024, 1024, 1024, 128};
        pg8::EpiSwiglu E{WSP(bf16_t, WS_DV)};
        pg8::gemm_phase<pg8::EpiSwiglu, MoeSched, true, true>(F.lds + RING_OFF, g, S, E);
        GRID_BAR();
    }
    if (IN(9)) {
        moe_tables(F, F.ctl + CW_CNT);
        MoeSched S{(const LAS int*)(F.lds + TAB_OFF), (const LAS int*)(F.lds + TAB_OFF) + 64, WSP(int, WS_LIST), 4, F.G, (int)blockIdx.x, 0};
        pg8::Gemm g{WSP(bf16_t, WS_DV), WSP(bf16_t, WS_CK), 256, 256, 256, 128};
        pg8::EpiPlain E{WSP(bf16_t, WS_Y), 1024, 3};
        pg8::gemm_phase<pg8::EpiPlain, MoeSched, true, false>(F.lds + RING_OFF, g, S, E);
        GRID_BAR();
    }
    if (IN(10)) {
        moe_tables(F, F.ctl + CW_CNT);
        p9_combine(F, args.out, WSP(bf16_t, WS_Y), WSP(unsigned, WS_TINFO));
    }
#ifdef DBG_DUMP_OFF
    if (args.li == N_LAUNCHES - 1) {
        __syncthreads();
        const bf16_t* src = DBG_DUMP_OUT ? (const bf16_t*)args.out : WSP(const bf16_t, DBG_DUMP_OFF);
        float* tmp = WSP(float, DBG_TMP_OFF);
        const int gt = F.vcu * (NWAVES * 64) + F.tid, NGT = F.G * NWAVES * 64;
        for (size_t idx = gt; idx < (size_t)T_TOK * 1024; idx += NGT) { const size_t t = idx >> 10; const int c = (int)(idx & 1023) % DBG_DUMP_COLS; tmp[idx] = bf2f(src[t * DBG_DUMP_LD + c]); }
    }
#endif
#undef IN
#undef GRID_BAR
#undef INP
#undef WSP
}

extern "C" void kernel_launch(void* const* d_in, const int* in_sizes, int n_in, void* d_out, int out_size, void* d_ws, size_t ws_size, hipStream_t stream) {
    static int grid = 0;
    if (grid == 0) {
        if (n_in != 22 || in_sizes[0] != T_TOK * D_MODEL || out_size != T_TOK * D_MODEL || ws_size < WS_END) {
            fprintf(stderr, "kernel_launch: shape/workspace mismatch: n_in %d in0 %d out %d ws %zu (need >= %zu); nothing launched\n", n_in, n_in > 0 ? in_sizes[0] : -1, out_size, ws_size, (size_t)WS_END); grid = -1; return; }
        int dev = 0, cus = 0, per_cu = 0;
        if (hipGetDevice(&dev) != hipSuccess || hipDeviceGetAttribute(&cus, hipDeviceAttributeMultiprocessorCount, dev) != hipSuccess) { fprintf(stderr, "kernel_launch: device query failed\n"); grid = -1; return; }
        if (hipFuncSetAttribute((const void*)fwd_kernel, hipFuncAttributeMaxDynamicSharedMemorySize, LDS_BYTES) != hipSuccess) { fprintf(stderr, "kernel_launch: hipFuncSetAttribute failed\n"); grid = -1; return; }
        if (hipOccupancyMaxActiveBlocksPerMultiprocessor(&per_cu, (const void*)fwd_kernel, NWAVES * 64, LDS_BYTES) != hipSuccess || per_cu < 1)
            fprintf(stderr, "kernel_launch: note: occupancy query reports %d workgroups per CU\n", per_cu);
        (void)hipGetLastError();
        grid = cus;
    }
    if (grid < 0) return;
    if (hipMemsetAsync((char*)d_ws + WS_CTL, 0, CTL_ZERO_BYTES, stream) != hipSuccess) { fprintf(stderr, "kernel_launch: hipMemsetAsync failed\n"); return; }
    Args a{};
    for (int i = 0; i < 22; ++i) a.in[i] = (const float*)d_in[i];
    a.positions = (const int*)d_in[1];
    a.out = (float*)d_out; a.ws = (unsigned char*)d_ws;
    for (int li = 0; li < N_LAUNCHES; ++li) {
        a.ph_lo = (N_LAUNCHES == 1) ? 0 : li; a.ph_hi = (N_LAUNCHES == 1) ? NPHASE : li + 1; a.li = li; a.pad = 0;
        hipLaunchKernelGGL(fwd_kernel, dim3(grid), dim3(NWAVES * 64), LDS_BYTES, stream, a);
        const hipError_t le = hipPeekAtLastError();
        if (le != hipSuccess) { fprintf(stderr, "kernel_launch: launch %d failed: %s\n", li, hipGetErrorName(le)); break; }
    }
#ifdef DBG_DUMP_OFF
    hipMemcpyAsync(d_out, (char*)d_ws + DBG_TMP_OFF, (size_t)T_TOK * 1024 * 4, hipMemcpyDeviceToDevice, stream);
#endif
}
```

```cpp
#include <hip/hip_runtime.h>
#include <hip/hip_bf16.h>
#include <cstdio>
#include <cstdint>
#include <cmath>

#ifndef DBG_GATE_EXPR
#define DBG_GATE_EXPR fast_sigmoid(v[e] + bv[e])
#endif
#define GAS __attribute__((address_space(1)))
#define LAS __attribute__((address_space(3)))
typedef unsigned short bf16_t;
typedef short bf16x8 __attribute__((ext_vector_type(8)));
typedef short s16x4 __attribute__((ext_vector_type(4)));
typedef float f32x2 __attribute__((ext_vector_type(2)));
typedef float f32x4 __attribute__((ext_vector_type(4)));
typedef float f32x16 __attribute__((ext_vector_type(16)));
typedef unsigned u32x2 __attribute__((ext_vector_type(2)));
typedef unsigned u32x4 __attribute__((ext_vector_type(4)));
typedef GAS unsigned gu32;
typedef GAS unsigned long long gu64;
#define RLX_AGENT __ATOMIC_RELAXED, __HIP_MEMORY_SCOPE_AGENT
#define LDS_WAIT() asm volatile("s_waitcnt lgkmcnt(0)" ::: "memory")
#define VM_WAIT() asm volatile("s_waitcnt vmcnt(0)" ::: "memory")
#define SBAR() __builtin_amdgcn_sched_barrier(0)

constexpr int D_MODEL = 1024, BATCH = 16, SEQ = 2048, T_TOK = BATCH * SEQ;
constexpr int IN_COLS = 7712;
constexpr int N1_TILES = 31, N1_PAD = N1_TILES * 256;
constexpr float EPS = 1e-6f, LOG2E = 1.4426950408889634f;
constexpr int NEXP = 32, EPG = 8, NGRP = 4, DFF = 256, LIST_CAP = T_TOK;
constexpr int LD_QM = 768, LD_CK = 320, LD_DIL = 1536, LD_G = 2048, LD_KM = 768, LD_VM = 512;
constexpr float QS_DIL = 0.125f * LOG2E;
constexpr float QS_MLA = 0.10206207261596575f * LOG2E;

typedef __bf16 bf16x2_t __attribute__((ext_vector_type(2)));
__device__ __forceinline__ unsigned cvt_pk_bf16(float lo, float hi) { f32x2 v = {lo, hi}; bf16x2_t b = __builtin_convertvector(v, bf16x2_t); return __builtin_bit_cast(unsigned, b); }
__device__ __forceinline__ float bf2f(unsigned short u) { return __uint_as_float(((unsigned)u) << 16); }
__device__ __forceinline__ float bflo(unsigned w) { return __uint_as_float(w << 16); }
__device__ __forceinline__ float bfhi(unsigned w) { return __uint_as_float(w & 0xffff0000u); }
__device__ __forceinline__ void unpack8(const u32x4 w, float* f) { f[0] = bflo(w.x); f[1] = bfhi(w.x); f[2] = bflo(w.y); f[3] = bfhi(w.y); f[4] = bflo(w.z); f[5] = bfhi(w.z); f[6] = bflo(w.w); f[7] = bfhi(w.w); }
__device__ __forceinline__ u32x4 pack8(const float* f) { u32x4 w; w.x = cvt_pk_bf16(f[0], f[1]); w.y = cvt_pk_bf16(f[2], f[3]); w.z = cvt_pk_bf16(f[4], f[5]); w.w = cvt_pk_bf16(f[6], f[7]); return w; }
__device__ __forceinline__ float fast_sigmoid(float z) { return __builtin_amdgcn_rcpf(1.0f + __builtin_amdgcn_exp2f(-z * LOG2E)); }
__device__ __forceinline__ float wave_sum(float v) {
#pragma unroll
    for (int o = 1; o < 64; o <<= 1) v += __shfl_xor(v, o);
    return v;
}
namespace pg8 {
#define PG8_LAS __attribute__((address_space(3)))
constexpr int BM = 256, BK = 64, HALF = 128, HTB = HALF * BK * 2  , STAGE_BYTES = 8 * HTB, NXCD = 8, WGM = 8;

__host__ __device__ __forceinline__ int lds_byte(int r, int c) { const int st = (r >> 4) * 2 + (c >> 5), rr = r & 15, cc = c & 31, ob = rr * 64 + cc * 2; return st * 1024 + (ob ^ (((ob >> 9) & 1) << 5)); }
__host__ __device__ __forceinline__ void stage_rc(int b, int& R, int& C) { const int st = b / 1024, sb = b % 1024, swz = sb ^ (((sb >> 9) & 1) << 5); R = (st >> 1) * 16 + swz / 64; C = (st & 1) * 32 + (swz % 64) / 2; }
__host__ __device__ __forceinline__ int perm32(int rho) { const int n = rho >> 4, i = rho & 15; return 8 * (i >> 2) + 4 * n + (i & 3); }

struct Unit { int pm, pn, aux; };
struct Gemm { const bf16_t* A; const bf16_t* Bt; int lda, ldb, K; int kstepA; };

struct StaticOrder {
    int nM, nN, nwg, G, c;
    __host__ __device__ void init(int M, int N, int G_, int c_) { nM = M / BM; nN = N / BM; nwg = nM * nN; G = G_; c = c_; }
    __host__ __device__ bool next(int i, Unit& u) const {
        const long L = (long)i * G + c; if (L >= nwg) return false;
        int wgid = (int)L; { const int q = nwg / NXCD, r = nwg % NXCD, xcd = wgid % NXCD, off = wgid / NXCD; wgid = (xcd < r ? xcd * (q + 1) : r * (q + 1) + (xcd - r) * q) + off; }
        const int nig = WGM * nN, gid = wgid / nig, fm = gid * WGM, gsz = (nM - fm) < WGM ? (nM - fm) : WGM;
        u.pm = fm + ((wgid % nig) % gsz); u.pn = (wgid % nig) / gsz; u.aux = 0; return true;
    }
    __device__ __forceinline__ unsigned row_off(const Unit&, int) const { return 0u; }
};

template <class Epi, class Sched, bool ALIGN_EPI, bool GATHER>
__device__ __forceinline__ void gemm_phase(PG8_LAS unsigned char* lds, const Gemm g, const Sched& S, const Epi& E) {
    int tid_ = threadIdx.x; asm volatile("" : "+v"(tid_));
    const int tid = tid_, wid = __builtin_amdgcn_readfirstlane(tid >> 6), lane = tid & 63, wr = wid >> 2, wc = wid & 3, fr = lane & 15, fq = lane >> 4;
    const int K = g.K, nt = K / BK;
    unsigned voffB[2]; unsigned vcur[2][2], vnxt[2][2]; int Rr[2], Cc[2];
#pragma unroll
    for (int i = 0; i < 2; ++i) { int R, C; stage_rc(tid * 16 + i * 8192, R, C); const int Rb = Epi::PERM ? ((R & ~31) + perm32(R & 31)) : R;
        Rr[i] = R; Cc[i] = C; voffB[i] = (unsigned)(Rb * g.ldb + C) * 2u;
        vcur[0][i] = (unsigned)(R * g.lda + C) * 2u; vcur[1][i] = (unsigned)((R + HALF) * g.lda + C) * 2u; vnxt[0][i] = vcur[0][i]; vnxt[1][i] = vcur[1][i]; }
    const size_t kstepA = (size_t)g.kstepA, kstepB = (size_t)(BK * 2);
    const size_t hstepB = (size_t)HALF * g.ldb * 2, tstepB = 2 * hstepB, tstepA = (size_t)BM * g.lda * 2;
    const unsigned ldsw = (unsigned)wid * 1024u;
    const int aoff = lds_byte(wr * 64 + fr, fq * 8), boff = lds_byte(wc * 32 + fr, fq * 8);
#define PG8_SA(b, h) (((b) * 2 + (h)) * HTB)
#define PG8_SB(b, h) ((4 + (b) * 2 + (h)) * HTB)
#define PG8_STAGE(bufoff, gbase, voff) do { _Pragma("unroll") for (int _i = 0; _i < 2; ++_i) \
        __builtin_amdgcn_global_load_lds((const unsigned*)((const char*)(gbase) + (voff)[_i]), (PG8_LAS unsigned*)(lds + (bufoff) + ldsw + _i * 8192), 16, 0, 0); } while (0)
#define PG8_LDA(dst, b, h) do { _Pragma("unroll") for (int m = 0; m < 4; ++m) _Pragma("unroll") for (int k = 0; k < 2; ++k) dst[m][k] = *(const PG8_LAS bf16x8*)(lds + PG8_SA(b, h) + aoff + m * 2048 + k * 1024); } while (0)
#define PG8_LDB(dst, b, h) do { _Pragma("unroll") for (int n = 0; n < 2; ++n) _Pragma("unroll") for (int k = 0; k < 2; ++k) dst[n][k] = *(const PG8_LAS bf16x8*)(lds + PG8_SB(b, h) + boff + n * 2048 + k * 1024); } while (0)
#define PG8_MMA(ai, bj, At, Bt) do { __builtin_amdgcn_s_setprio(1); _Pragma("unroll") for (int m = 0; m < 4; ++m) _Pragma("unroll") for (int n = 0; n < 2; ++n) _Pragma("unroll") for (int k = 0; k < 2; ++k) \
        acc[ai][bj][m][n] = __builtin_amdgcn_mfma_f32_16x16x32_bf16(Bt[n][k], At[m][k], acc[ai][bj][m][n], 0, 0, 0); __builtin_amdgcn_s_setprio(0); } while (0)
#define PG8_WAIT_V(n) asm volatile("s_waitcnt vmcnt(" #n ")" ::: "memory")
#define PG8_WAIT_L(n) asm volatile("s_waitcnt lgkmcnt(" #n ")" ::: "memory")
#define PG8_BAR __builtin_amdgcn_s_barrier()
#define PG8_SCHED __builtin_amdgcn_sched_barrier(0)
    Unit cur, nxt; int ui = 0;
    if (!S.next(0, cur)) return;
    if constexpr (GATHER) {
#pragma unroll
        for (int h = 0; h < 2; ++h)
#pragma unroll
            for (int i = 0; i < 2; ++i) { vcur[h][i] = S.row_off(cur, h * HALF + Rr[i]) + (unsigned)Cc[i] * 2u; vnxt[h][i] = vcur[h][i]; }
    }
    f32x4 acc[2][2][4][2];
#pragma unroll
    for (int a = 0; a < 2; ++a)
#pragma unroll
        for (int b = 0; b < 2; ++b)
#pragma unroll
            for (int m = 0; m < 4; ++m)
#pragma unroll
                for (int n = 0; n < 2; ++n) acc[a][b][m][n] = (f32x4){0.f, 0.f, 0.f, 0.f};
    bf16x8 At[4][2], B0[2][2], B1[2][2];
    const char* cA = (const char*)g.A + (GATHER ? (size_t)0 : (size_t)cur.pm * tstepA); const char* cB = (const char*)g.Bt + (size_t)cur.pn * tstepB;
    PG8_STAGE(PG8_SB(0, 0), cB, voffB); PG8_STAGE(PG8_SB(0, 1), cB + hstepB, voffB); PG8_STAGE(PG8_SA(0, 0), cA, vcur[0]); PG8_STAGE(PG8_SA(0, 1), cA, vcur[1]);
    if (wr == 1) PG8_BAR;
    PG8_WAIT_V(2); PG8_BAR;
    PG8_STAGE(PG8_SB(1, 0), cB + kstepB, voffB); PG8_STAGE(PG8_SA(1, 0), cA + kstepA, vcur[0]); PG8_STAGE(PG8_SB(1, 1), cB + hstepB + kstepB, voffB);
    PG8_WAIT_V(6); PG8_BAR;
    for (;;) {
        const bool has_next = S.next(ui + 1, nxt);
        const char* nA = has_next ? (const char*)g.A + (GATHER ? (size_t)0 : (size_t)nxt.pm * tstepA) : cA; const char* nB = has_next ? (const char*)g.Bt + (size_t)nxt.pn * tstepB : cB;
        if constexpr (GATHER) {
            if (has_next) {
#pragma unroll
                for (int h = 0; h < 2; ++h)
#pragma unroll
                    for (int i = 0; i < 2; ++i) vnxt[h][i] = S.row_off(nxt, h * HALF + Rr[i]) + (unsigned)Cc[i] * 2u;
            } else {
#pragma unroll
                for (int h = 0; h < 2; ++h)
#pragma unroll
                    for (int i = 0; i < 2; ++i) vnxt[h][i] = vcur[h][i];
            }
        }
#pragma unroll 1
        for (int t = 0; t < nt; t += 2) {
            const bool last = (t == nt - 2);
            const char* a1 = cA + (size_t)(t + 1) * kstepA;
            const char* a2 = last ? nA : cA + (size_t)(t + 2) * kstepA; const char* b2 = last ? nB : cB + (size_t)(t + 2) * kstepB;
            const char* a3 = a2 + kstepA; const char* b3 = b2 + kstepB;
            unsigned vsel[2][2];
#pragma unroll
            for (int h = 0; h < 2; ++h)
#pragma unroll
                for (int i = 0; i < 2; ++i) vsel[h][i] = (GATHER && last) ? vnxt[h][i] : vcur[h][i];
            PG8_LDB(B0, 0, 0); PG8_LDB(B1, 0, 1); PG8_SCHED; PG8_LDA(At, 0, 0); PG8_STAGE(PG8_SA(1, 1), a1, vcur[1]);
            PG8_WAIT_V(8); PG8_WAIT_L(0); PG8_BAR; PG8_MMA(0, 0, At, B0); PG8_MMA(0, 1, At, B1); PG8_BAR; PG8_SCHED;
            PG8_LDA(At, 0, 1); PG8_STAGE(PG8_SB(0, 0), b2, voffB); PG8_STAGE(PG8_SB(0, 1), b2 + hstepB, voffB); PG8_STAGE(PG8_SA(0, 0), a2, vsel[0]);
            PG8_WAIT_V(8); PG8_WAIT_L(0); PG8_BAR; PG8_MMA(1, 0, At, B0); PG8_MMA(1, 1, At, B1); PG8_BAR; PG8_SCHED;
            PG8_LDB(B0, 1, 0); PG8_LDB(B1, 1, 1); PG8_SCHED; PG8_LDA(At, 1, 0); PG8_STAGE(PG8_SA(0, 1), a2, vsel[1]);
            PG8_WAIT_V(8); PG8_WAIT_L(0); PG8_BAR; PG8_MMA(0, 0, At, B0); PG8_MMA(0, 1, At, B1); PG8_BAR; PG8_SCHED;
            PG8_LDA(At, 1, 1); PG8_STAGE(PG8_SB(1, 0), b3, voffB); PG8_STAGE(PG8_SB(1, 1), b3 + hstepB, voffB); PG8_STAGE(PG8_SA(1, 0), a3, vsel[0]);
            PG8_WAIT_V(8); PG8_WAIT_L(0); PG8_BAR; PG8_MMA(1, 0, At, B0); PG8_MMA(1, 1, At, B1); PG8_BAR; PG8_SCHED;
        }
        if constexpr (ALIGN_EPI) { if (wr == 0) PG8_BAR; }
        E(acc, cur, wr, wc, fr, fq);
        if (!has_next) break;
#pragma unroll
        for (int a = 0; a < 2; ++a)
#pragma unroll
            for (int b = 0; b < 2; ++b)
#pragma unroll
                for (int m = 0; m < 4; ++m)
#pragma unroll
                    for (int n = 0; n < 2; ++n) acc[a][b][m][n] = (f32x4){0.f, 0.f, 0.f, 0.f};
        cur = nxt; cA = nA; cB = nB; ++ui;
        if constexpr (GATHER) {
#pragma unroll
            for (int h = 0; h < 2; ++h)
#pragma unroll
                for (int i = 0; i < 2; ++i) vcur[h][i] = vnxt[h][i];
        }
        if constexpr (ALIGN_EPI) { if (wr == 1) PG8_BAR; }
    }
    PG8_WAIT_V(0);
    if constexpr (!ALIGN_EPI) { if (wr == 0) PG8_BAR; }
    PG8_BAR;
#undef PG8_SA
#undef PG8_SB
#undef PG8_STAGE
#undef PG8_LDA
#undef PG8_LDB
#undef PG8_MMA
#undef PG8_WAIT_V
#undef PG8_WAIT_L
#undef PG8_BAR
#undef PG8_SCHED
}
}
constexpr size_t MiB = 1u << 20;
constexpr size_t WS_CTL = 0, CTL_ZERO_BYTES = 1 * MiB;
constexpr size_t WS_WIN = 1 * MiB;
constexpr size_t WS_WUKV = 17 * MiB;
constexpr size_t WS_WOM = 18 * MiB;
constexpr size_t WS_WOD = 19 * MiB;
constexpr size_t WS_WOUT = 20 * MiB;
constexpr size_t WS_ROPE = 22 * MiB;
constexpr size_t WS_CKS = 26 * MiB;
constexpr size_t WS_TINFO = 27 * MiB;
constexpr size_t WS_LIST = 28 * MiB;
constexpr size_t WS_B = 32 * MiB;
constexpr size_t WS_VM = 96 * MiB;
constexpr size_t WS_QM = 128 * MiB;
constexpr size_t WS_CK = 176 * MiB;
constexpr size_t WS_DQ = 196 * MiB;
constexpr size_t WS_DK = 292 * MiB;
constexpr size_t WS_DV = 388 * MiB;
constexpr size_t WS_END = 484 * MiB;
constexpr size_t WS_Y = WS_DQ;
constexpr int MAX_SLOT_ROWS = 65536 + 32 * 256;
static_assert(WS_Y + (size_t)MAX_SLOT_ROWS * 1024 * 2 <= WS_DV, "Y fits DQ|DK");
constexpr int CW_TMO = 0, CW_CODE = 1;
constexpr int CW_BAR = 4096;
constexpr int CW_CNT = 8192;

constexpr int RING_OFF = 0, RING_BYTES = 131072;
constexpr int TAB_OFF = 131072;
constexpr int LDSCTL_OFF = 147456, MISC_OFF = LDSCTL_OFF + 320;
constexpr int LDS_BYTES = 148480;
static_assert(MISC_OFF + 128 <= LDS_BYTES, "LDS map");

#define XB_TMO      128
#define XB_XCNT(j)  (256  + 64 * (j))
#define XB_XSUB(j)  (1280 + 64 * (j))
#define XB_XGEN(j)  (2304 + 64 * (j))
#define XB_TOP      3328
#define XB_TOPGEN   3392
#define XCD_BAR_WORDS 3456
#define XB_SPIN_CAP (1u << 18)

__device__ __forceinline__ unsigned xb_ld(unsigned* p)              { return __hip_atomic_load(p, __ATOMIC_RELAXED, __HIP_MEMORY_SCOPE_AGENT); }
__device__ __forceinline__ unsigned xb_add(unsigned* p, unsigned v) { return __hip_atomic_fetch_add(p, v, __ATOMIC_RELAXED, __HIP_MEMORY_SCOPE_AGENT); }
__device__ __forceinline__ unsigned xb_xcc_id() { return (unsigned)__builtin_amdgcn_s_getreg((3 << 11) | 20) & 0xFu; }
#define XB_SPIN(cond, bar) do { unsigned _sp = 0; while (cond) { __builtin_amdgcn_s_sleep(1); \
    if ((++_sp & 255u) == 0u) { if (xb_ld(&(bar)[XB_TMO])) break; if (_sp > XB_SPIN_CAP) { atomicAdd(&(bar)[XB_TMO], 1u); break; } } } } while (0)

struct XcdBarrier {
    unsigned* bar; unsigned x;
    volatile LAS unsigned* st;
};
__device__ __forceinline__ XcdBarrier xcd_barrier_post(unsigned* bar, volatile LAS unsigned* st) {
    XcdBarrier b; b.bar = bar; b.x = xb_xcc_id(); b.st = st;
    if (threadIdx.x == 0) (void)xb_add(&bar[XB_XCNT(b.x)], 1u);
    return b;
}
__device__ __forceinline__ void xcd_barrier_complete(unsigned* bar, unsigned x, unsigned& nloc, unsigned& nx) {
    const unsigned G = gridDim.x * gridDim.y * gridDim.z;
    unsigned sum, cnt, mine, sp = 0u;
    for (;;) {
        sum = 0u; cnt = 0u; mine = 0u;
#pragma unroll
        for (unsigned j = 0; j < 16; ++j) { const unsigned c = xb_ld(&bar[XB_XCNT(j)]); sum += c; cnt += (c > 0u) ? 1u : 0u; mine = (j == x) ? c : mine; }
        if (sum == G) break;
        __builtin_amdgcn_s_sleep(1);
        if ((++sp & 255u) == 0u) { if (xb_ld(&bar[XB_TMO])) break; if (sp > XB_SPIN_CAP) { atomicAdd(&bar[XB_TMO], 1u); break; } }
    }
    nloc = mine > 0u ? mine : 1u; nx = cnt > 0u ? cnt : 1u;
}
__device__ __forceinline__ void xcd_barrier(const XcdBarrier& b) {
    asm volatile("s_waitcnt vmcnt(0)" ::: "memory");
    __syncthreads();
    if (threadIdx.x == 0) {
        unsigned* bar = b.bar;
        __builtin_amdgcn_s_waitcnt(0);
        unsigned nloc = b.st[0], nx = b.st[1];
        if (nloc == 0u) { xcd_barrier_complete(bar, b.x, nloc, nx); b.st[0] = nloc; b.st[1] = nx; }
        const unsigned old = xb_add(&bar[XB_XSUB(b.x)], 1u);
        const unsigned gen = old / nloc;
        if (old + 1u == (gen + 1u) * nloc) {
            __builtin_amdgcn_fence(__ATOMIC_RELEASE, "agent");
            asm volatile("s_waitcnt vmcnt(0)" ::: "memory");
            const unsigned og = xb_add(&bar[XB_TOP], 1u);
            const unsigned tg = og / nx;
            if (og + 1u == (tg + 1u) * nx) xb_add(&bar[XB_TOPGEN], 1u);
            else XB_SPIN(xb_ld(&bar[XB_TOPGEN]) == tg, bar);
            __builtin_amdgcn_fence(__ATOMIC_ACQUIRE, "agent");
            xb_add(&bar[XB_XGEN(b.x)], 1u);
            asm volatile("s_waitcnt vmcnt(0)" ::: "memory");
        } else {
            XB_SPIN(xb_ld(&bar[XB_XGEN(b.x)]) == gen, bar);
            __builtin_amdgcn_fence(__ATOMIC_ACQUIRE, "agent");
            asm volatile("s_waitcnt vmcnt(0)" ::: "memory");
        }
    }
    __syncthreads();
}

constexpr int NWAVES = 8;
struct Frame {
    LAS unsigned char* lds;
    volatile LAS unsigned* MISC;
    gu32* ctl;
    int tid, lane, wave;
    int vcu, G;
};
namespace pg8 {
#define EPI_ROW16(v, acc, ai, m) float v[16]; _Pragma("unroll") for (int bj_ = 0; bj_ < 2; ++bj_) _Pragma("unroll") for (int n_ = 0; n_ < 2; ++n_) _Pragma("unroll") for (int j_ = 0; j_ < 4; ++j_) v[8 * bj_ + 4 * n_ + j_] = acc[ai][bj_][m][n_][j_]

struct EpiPlain {
    static constexpr bool PERM = true;
    bf16_t* O; int ldc; int pn_mask;
    __device__ __forceinline__ void operator()(const f32x4 (&acc)[2][2][4][2], const Unit& u, int wr, int wc, int fr, int fq) const {
        const int row0 = u.pm * BM + wr * 64 + fr, col0 = (u.pn & pn_mask) * BM + wc * 32 + 8 * fq;
#pragma unroll
        for (int ai = 0; ai < 2; ++ai)
#pragma unroll
            for (int m = 0; m < 4; ++m) { bf16_t* rowp = O + (size_t)(row0 + ai * HALF + m * 16) * ldc + col0;
#pragma unroll
                for (int bj = 0; bj < 2; ++bj) { const f32x4 v0 = acc[ai][bj][m][0], v1 = acc[ai][bj][m][1]; u32x4 w; w.x = cvt_pk_bf16(v0[0], v0[1]); w.y = cvt_pk_bf16(v0[2], v0[3]); w.z = cvt_pk_bf16(v1[0], v1[1]); w.w = cvt_pk_bf16(v1[2], v1[3]);
                    *(u32x4*)(rowp + bj * HALF) = w; } }
    }
};

struct Epi1 {
    static constexpr bool PERM = true;
    bf16_t *Qm, *CK, *DQ, *DK, *DV, *G; float* CKS; const float *bgate, *gq, *gk;
    __device__ __forceinline__ void operator()(const f32x4 (&acc)[2][2][4][2], const Unit& u, int wr, int wc, int fr, int fq) const {
        const int row0 = u.pm * BM + wr * 64 + fr, pn = u.pn;
        if (pn < 3) {
#pragma unroll
            for (int ai = 0; ai < 2; ++ai)
#pragma unroll
                for (int m = 0; m < 4; ++m) { EPI_ROW16(v, acc, ai, m); bf16_t* rowp = Qm + (size_t)(row0 + ai * HALF + m * 16) * LD_QM + pn * 256 + wc * 32 + 8 * fq;
                    *(u32x4*)(rowp) = pack8(v); *(u32x4*)(rowp + HALF) = pack8(v + 8); }
        } else if (pn == 3) {
#pragma unroll
            for (int ai = 0; ai < 2; ++ai)
#pragma unroll
                for (int m = 0; m < 4; ++m) { EPI_ROW16(v, acc, ai, m); const int row = row0 + ai * HALF + m * 16; bf16_t* rowp = CK + (size_t)row * LD_CK + wc * 32 + 8 * fq;
                    float s = 0.f;
#pragma unroll
                    for (int e = 0; e < 16; ++e) s += v[e] * v[e];
                    s += __shfl_xor(s, 16); s += __shfl_xor(s, 32);
                    if (fq == 0) CKS[(size_t)row * 4 + wc] = s;
                    *(u32x4*)(rowp) = pack8(v); *(u32x4*)(rowp + HALF) = pack8(v + 8); }
        } else if (pn < 16) {
            const bool isq = pn < 10; const int idx = pn - (isq ? 4 : 10), g = idx >> 1, h = 4 * (idx & 1) + wc;
            const float* gain = (isq ? gq : gk) + g * 64; const float qs = isq ? QS_DIL : 1.0f;
            float gn[16];
#pragma unroll
            for (int bj = 0; bj < 2; ++bj) { const f32x4 a = *(const f32x4*)(gain + 32 * bj + 8 * fq), b = *(const f32x4*)(gain + 32 * bj + 8 * fq + 4);
#pragma unroll
                for (int j = 0; j < 4; ++j) { gn[8 * bj + j] = a[j] * qs; gn[8 * bj + 4 + j] = b[j] * qs; } }
            bf16_t* base = (isq ? DQ : DK) + g * 512 + h * 64 + 8 * fq;
#pragma unroll
            for (int ai = 0; ai < 2; ++ai)
#pragma unroll
                for (int m = 0; m < 4; ++m) { EPI_ROW16(v, acc, ai, m); const int row = row0 + ai * HALF + m * 16;
                    float s = 0.f;
#pragma unroll
                    for (int e = 0; e < 16; ++e) s += v[e] * v[e];
                    s += __shfl_xor(s, 16); s += __shfl_xor(s, 32);
                    const float rstd = 1.0f / sqrtf(s * (1.0f / 64.0f) + EPS);
#pragma unroll
                    for (int e = 0; e < 16; ++e) v[e] = v[e] * rstd * gn[e];
                    bf16_t* rowp = base + (size_t)row * LD_DIL;
                    *(u32x4*)(rowp) = pack8(v); *(u32x4*)(rowp + 32) = pack8(v + 8); }
        } else if (pn < 22) {
            const int idx = pn - 16, g = idx >> 1, h = 4 * (idx & 1) + wc;
            bf16_t* base = DV + g * 512 + h * 64 + 8 * fq;
#pragma unroll
            for (int ai = 0; ai < 2; ++ai)
#pragma unroll
                for (int m = 0; m < 4; ++m) { EPI_ROW16(v, acc, ai, m); bf16_t* rowp = base + (size_t)(row0 + ai * HALF + m * 16) * LD_DIL;
                    *(u32x4*)(rowp) = pack8(v); *(u32x4*)(rowp + 32) = pack8(v + 8); }
        } else if (pn < 30) {
            const int c0 = (pn - 22) * 256 + wc * 32 + 8 * fq;
            float bv[16];
#pragma unroll
            for (int bj = 0; bj < 2; ++bj) { const f32x4 a = *(const f32x4*)(bgate + c0 + 128 * bj), b = *(const f32x4*)(bgate + c0 + 128 * bj + 4);
#pragma unroll
                for (int j = 0; j < 4; ++j) { bv[8 * bj + j] = a[j]; bv[8 * bj + 4 + j] = b[j]; } }
#pragma unroll
            for (int ai = 0; ai < 2; ++ai)
#pragma unroll
                for (int m = 0; m < 4; ++m) { EPI_ROW16(v, acc, ai, m); bf16_t* rowp = G + (size_t)(row0 + ai * HALF + m * 16) * LD_G + c0;
#pragma unroll
                    for (int e = 0; e < 16; ++e) v[e] = DBG_GATE_EXPR;
                    *(u32x4*)(rowp) = pack8(v); *(u32x4*)(rowp + HALF) = pack8(v + 8); }
        } else {
            if (wc == 0) {
#pragma unroll
                for (int ai = 0; ai < 2; ++ai)
#pragma unroll
                    for (int m = 0; m < 4; ++m) { EPI_ROW16(v, acc, ai, m); bf16_t* rowp = CK + (size_t)(row0 + ai * HALF + m * 16) * LD_CK + 256 + 8 * fq;
                        *(u32x4*)(rowp) = pack8(v); }
            }
        }
    }
};

struct Epi2 {
    static constexpr bool PERM = true;
    bf16_t *KM, *VM; const bf16_t* CK; const float *CKS, *gkm, *cs, *sn;
    __device__ __forceinline__ void operator()(const f32x4 (&acc)[2][2][4][2], const Unit& u, int wr, int wc, int fr, int fq) const {
        const int row0 = u.pm * BM + wr * 64 + fr, pn = u.pn;
        if (pn < 2) {
            const int h = 4 * pn + wc;
            const int own0 = 8 * fq, par0 = 8 * (fq ^ 2), ip0 = (8 * fq) & 15;
            float rstdk[8];
            {
                float gn[16];
#pragma unroll
                for (int bj = 0; bj < 2; ++bj) { const f32x4 a = *(const f32x4*)(gkm + 32 * bj + 8 * fq), b = *(const f32x4*)(gkm + 32 * bj + 8 * fq + 4);
#pragma unroll
                    for (int j = 0; j < 4; ++j) { gn[8 * bj + j] = a[j]; gn[8 * bj + 4 + j] = b[j]; } }
#pragma unroll
                for (int ai = 0; ai < 2; ++ai)
#pragma unroll
                    for (int m = 0; m < 4; ++m) { EPI_ROW16(v, acc, ai, m); const int row = row0 + ai * HALF + m * 16;
                        const f32x4 ps = *(const f32x4*)(CKS + (size_t)row * 4);
                        const float rs = 1.0f / sqrtf(((ps[0] + ps[1]) + (ps[2] + ps[3])) * (1.0f / 256.0f) + EPS);
                        float s = 0.f;
#pragma unroll
                        for (int e = 0; e < 16; ++e) { v[e] *= rs; s += v[e] * v[e]; }
                        float ko[8];
                        unpack8(*(const u32x4*)(CK + (size_t)row * LD_CK + 256 + own0), ko);
#pragma unroll
                        for (int j = 0; j < 8; ++j) s += ko[j] * ko[j];
                        s += __shfl_xor(s, 16); s += __shfl_xor(s, 32);
                        const float rstd = 1.0f / sqrtf(s * (1.0f / 96.0f) + EPS);
                        rstdk[ai * 4 + m] = rstd;
#pragma unroll
                        for (int e = 0; e < 16; ++e) v[e] = v[e] * rstd * gn[e];
                        bf16_t* rowp = KM + (size_t)row * LD_KM + h * 96;
                        *(u32x4*)(rowp + 8 * fq) = pack8(v); *(u32x4*)(rowp + 32 + 8 * fq) = pack8(v + 8);
                        asm volatile("" ::: "memory"); }
            }
            {
                float gr_own[8], gr_par[8];
#pragma unroll
                for (int j = 0; j < 8; ++j) { gr_own[j] = gkm[64 + own0 + j]; gr_par[j] = gkm[64 + par0 + j]; }
#pragma unroll
                for (int ai = 0; ai < 2; ++ai)
#pragma unroll
                    for (int m = 0; m < 4; ++m) { const int row = row0 + ai * HALF + m * 16; const float rstd = rstdk[ai * 4 + m];
                        float ko[8], kp[8];
                        unpack8(*(const u32x4*)(CK + (size_t)row * LD_CK + 256 + own0), ko); unpack8(*(const u32x4*)(CK + (size_t)row * LD_CK + 256 + par0), kp);
                        const f32x4 c0 = *(const f32x4*)(cs + (size_t)row * 16 + ip0), c1 = *(const f32x4*)(cs + (size_t)row * 16 + ip0 + 4);
                        const f32x4 n0 = *(const f32x4*)(sn + (size_t)row * 16 + ip0), n1 = *(const f32x4*)(sn + (size_t)row * 16 + ip0 + 4);
                        float ro[8];
#pragma unroll
                        for (int j = 0; j < 8; ++j) { const float c = j < 4 ? c0[j & 3] : c1[j & 3], sv = j < 4 ? n0[j & 3] : n1[j & 3];
                            const float a = ko[j] * gr_own[j], b = kp[j] * gr_par[j];
                            ro[j] = (fq < 2 ? (a * c - b * sv) : (a * c + b * sv)) * rstd; }
                        *(u32x4*)(KM + (size_t)row * LD_KM + h * 96 + 64 + own0) = pack8(ro);
                        asm volatile("" ::: "memory"); }
            }
        } else {
            const int h = 4 * (pn - 2) + wc;
#pragma unroll
            for (int ai = 0; ai < 2; ++ai)
#pragma unroll
                for (int m = 0; m < 4; ++m) { EPI_ROW16(v, acc, ai, m); const int row = row0 + ai * HALF + m * 16;
                    const f32x4 ps = *(const f32x4*)(CKS + (size_t)row * 4);
                    const float rs = 1.0f / sqrtf(((ps[0] + ps[1]) + (ps[2] + ps[3])) * (1.0f / 256.0f) + EPS);
#pragma unroll
                    for (int e = 0; e < 16; ++e) v[e] *= rs;
                    bf16_t* rowp = VM + (size_t)row * LD_VM + h * 64 + 8 * fq;
                    *(u32x4*)(rowp) = pack8(v); *(u32x4*)(rowp + 32) = pack8(v + 8); }
        }
    }
};

struct EpiMerge {
    static constexpr bool PERM = true;
    bf16_t* MG; const bf16_t *UM, *G;
    __device__ __forceinline__ void operator()(const f32x4 (&acc)[2][2][4][2], const Unit& u, int wr, int wc, int fr, int fq) const {
        const int row0 = u.pm * BM + wr * 64 + fr, col0 = u.pn * BM + wc * 32 + 8 * fq;
#pragma unroll
        for (int ai = 0; ai < 2; ++ai)
#pragma unroll
            for (int m = 0; m < 4; ++m) { const int row = row0 + ai * HALF + m * 16;
#pragma unroll
                for (int bj = 0; bj < 2; ++bj) { const int col = col0 + bj * HALF;
                    float s0[8], s1[8], um[8], o[8];
                    unpack8(*(const u32x4*)(G + (size_t)row * LD_G + col), s0); unpack8(*(const u32x4*)(G + (size_t)row * LD_G + 1024 + col), s1); unpack8(*(const u32x4*)(UM + (size_t)row * 1024 + col), um);
#pragma unroll
                    for (int j = 0; j < 8; ++j) o[j] = s1[j] * acc[ai][bj][m][j >> 2][j & 3] + s0[j] * um[j];
                    *(u32x4*)(MG + (size_t)row * 1024 + col) = pack8(o); } }
    }
};

struct EpiResid {
    static constexpr bool PERM = false;
    const float* X; float* O;
    __device__ __forceinline__ void operator()(const f32x4 (&acc)[2][2][4][2], const Unit& u, int wr, int wc, int fr, int fq) const {
        const int row0 = u.pm * BM + wr * 64 + fr, col0 = u.pn * BM + wc * 32 + 4 * fq;
#pragma unroll
        for (int ai = 0; ai < 2; ++ai)
#pragma unroll
            for (int m = 0; m < 4; ++m) { const size_t off = (size_t)(row0 + ai * HALF + m * 16) * 1024 + col0;
#pragma unroll
                for (int bj = 0; bj < 2; ++bj)
#pragma unroll
                    for (int n = 0; n < 2; ++n) *(f32x4*)(O + off + bj * HALF + n * 16) = *(const f32x4*)(X + off + bj * HALF + n * 16) + acc[ai][bj][m][n]; }
    }
};

struct EpiSwiglu {
    static constexpr bool PERM = true;
    bf16_t* HE;
    __device__ __forceinline__ void operator()(const f32x4 (&acc)[2][2][4][2], const Unit& u, int wr, int wc, int fr, int fq) const {
        const int row0 = u.pm * BM + wr * 64 + fr, col0 = (u.pn & 1) * 128 + wc * 32 + 8 * fq;
#pragma unroll
        for (int ai = 0; ai < 2; ++ai)
#pragma unroll
            for (int m = 0; m < 4; ++m) { float o[8];
#pragma unroll
                for (int j = 0; j < 8; ++j) { const float gt = acc[ai][0][m][j >> 2][j & 3], up = acc[ai][1][m][j >> 2][j & 3]; o[j] = gt * fast_sigmoid(gt) * up; }
                *(u32x4*)(HE + (size_t)(row0 + ai * HALF + m * 16) * DFF + col0) = pack8(o); }
    }
};
#undef EPI_ROW16
}
__device__ __forceinline__ void transpose_item(const float* W, int ldw, int k0, int n0, bf16_t* WT, int ldt, int dst_row0, const float* kscale, LAS float* scr, int lane) {
#pragma unroll 8
    for (int i = 0; i < 32; ++i) { const int kk = 2 * i + (lane >> 5); float v = W[(size_t)(k0 + kk) * ldw + n0 + (lane & 31)]; if (kscale) v *= kscale[k0 + kk]; scr[kk * 33 + (lane & 31)] = v; }
    LDS_WAIT(); asm volatile("" ::: "memory");
    const int c = lane & 7;
#pragma unroll
    for (int j = 0; j < 4; ++j) { const int n = (lane >> 3) + 8 * j; const LAS float* s = scr + (8 * c) * 33 + n;
        u32x4 o; o.x = cvt_pk_bf16(s[0 * 33], s[1 * 33]); o.y = cvt_pk_bf16(s[2 * 33], s[3 * 33]); o.z = cvt_pk_bf16(s[4 * 33], s[5 * 33]); o.w = cvt_pk_bf16(s[6 * 33], s[7 * 33]);
        *(GAS u32x4*)(WT + (size_t)(dst_row0 + n) * ldt + k0 + 8 * c) = o; }
    LDS_WAIT(); asm volatile("" ::: "memory");
}
__host__ __device__ __forceinline__ int win_row(int n) {
    if (n < 1024) return n;
    if (n < 1056) return 30 * 256 + (n - 1024);
    if (n < 5664) { const int mm = n - 1056, sg = mm / 512, hh = (mm % 512) / 64, d = mm % 64; const int pn = 4 + sg * 2 + (hh >> 2); return pn * 256 + (d >> 5) * 128 + (hh & 3) * 32 + (d & 31); }
    return 22 * 256 + (n - 5664);
}
__host__ __device__ __forceinline__ int wukv_row(int n) {
    const int h = n >> 7, c = n & 127, isv = c >> 6, d = c & 63; const int pn = 2 * isv + (h >> 2); return pn * 256 + (d >> 5) * 128 + (h & 3) * 32 + (d & 31);
}

struct P0Args { const float *x, *norm_attn, *w_in, *norm_ckv, *w_ukv, *w_o_mla, *w_o_dil, *w_out; const int* positions; bf16_t *WinT, *WukvT, *WoMT, *WoDT, *WoutT, *XN; float *cs, *sn; };
__device__ __forceinline__ void p0_prologue(Frame& F, const P0Args& a) {
    LAS float* scr = (LAS float*)(F.lds + RING_OFF + F.wave * 16384);
    const int gw = F.vcu * NWAVES + F.wave, NGW = F.G * NWAVES;
    constexpr int I_IN = 16 * (IN_COLS / 32), I_UKV = 4 * 32, I_OM = 8 * 32, I_OD = 8 * 32, I_OUT = 16 * 32, I_PAD = 224;
    constexpr int NITEMS = I_IN + I_UKV + I_OM + I_OD + I_OUT + I_PAD;
    for (int it = gw; it < NITEMS; it += NGW) {
        int r = it;
        if (r < I_IN) { const int nb = r % (IN_COLS / 32), kb = r / (IN_COLS / 32); transpose_item(a.w_in, IN_COLS, 64 * kb, 32 * nb, a.WinT, 1024, win_row(32 * nb), nullptr, scr, F.lane); continue; } r -= I_IN;
        if (r < I_UKV) { const int nb = r % 32, kb = r / 32; transpose_item(a.w_ukv, 1024, 64 * kb, 32 * nb, a.WukvT, 256, wukv_row(32 * nb), a.norm_ckv, scr, F.lane); continue; } r -= I_UKV;
        if (r < I_OM) { const int nb = r % 32, kb = r / 32; transpose_item(a.w_o_mla, 1024, 64 * kb, 32 * nb, a.WoMT, 512, 32 * nb, nullptr, scr, F.lane); continue; } r -= I_OM;
        if (r < I_OD) { const int nb = r % 32, kb = r / 32; transpose_item(a.w_o_dil, 1024, 64 * kb, 32 * nb, a.WoDT, 512, 32 * nb, nullptr, scr, F.lane); continue; } r -= I_OD;
        if (r < I_OUT) { const int nb = r % 32, kb = r / 32; transpose_item(a.w_out, 1024, 64 * kb, 32 * nb, a.WoutT, 1024, 32 * nb, nullptr, scr, F.lane); continue; } r -= I_OUT;
        { GAS u32x4* z = (GAS u32x4*)(a.WinT + (size_t)(30 * 256 + 32 + r) * 1024) + F.lane; z[0] = (u32x4){0u, 0u, 0u, 0u}; z[64] = (u32x4){0u, 0u, 0u, 0u}; }
    }
    f32x4 gv[4];
#pragma unroll
    for (int j = 0; j < 4; ++j) gv[j] = ((const GAS f32x4*)a.norm_attn)[F.lane + 64 * j];
    for (int m = gw; m < T_TOK; m += NGW) {
        const GAS f32x4* xr = (const GAS f32x4*)(a.x + (size_t)m * D_MODEL) + F.lane;
        f32x4 v[4]; float s = 0.f;
#pragma unroll
        for (int j = 0; j < 4; ++j) { v[j] = xr[64 * j]; s += (v[j].x * v[j].x + v[j].y * v[j].y) + (v[j].z * v[j].z + v[j].w * v[j].w); }
        const float rstd = 1.f / sqrtf(wave_sum(s) * (1.f / D_MODEL) + EPS);
        GAS u32x2* o8 = (GAS u32x2*)(a.XN + (size_t)m * D_MODEL) + F.lane;
#pragma unroll
        for (int j = 0; j < 4; ++j) { u32x2 w; w.x = cvt_pk_bf16(v[j].x * rstd * gv[j].x, v[j].y * rstd * gv[j].y); w.y = cvt_pk_bf16(v[j].z * rstd * gv[j].z, v[j].w * rstd * gv[j].w); o8[64 * j] = w; }
    }
    const int gt = F.vcu * (NWAVES * 64) + F.tid, NGT = F.G * NWAVES * 64;
    for (int idx = gt; idx < T_TOK * 16; idx += NGT) {
        const int t = idx >> 4, i = idx & 15;
        const float freq = exp2f(-(float)i * (13.287712379549449f / 16.0f));
        const float ang = (float)a.positions[t] * freq;
        float sv, cv; sincosf(ang, &sv, &cv);
        a.cs[idx] = cv; a.sn[idx] = sv;
    }
}

struct P6Args { const float *w_gate, *w_up, *w_down; bf16_t *WguT, *WdT; };
__device__ __forceinline__ void p6_weights(Frame& F, const P6Args& a) {
    LAS float* scr = (LAS float*)(F.lds + RING_OFF + F.wave * 16384);
    const int gw = F.vcu * NWAVES + F.wave, NGW = F.G * NWAVES;
    constexpr int I_G = 16 * 8, I_D = 4 * 32;
    constexpr int NITEMS = NEXP * (2 * I_G + I_D);
    for (int it = gw; it < NITEMS; it += NGW) {
        const int e = it / (2 * I_G + I_D); int r = it % (2 * I_G + I_D);
        if (r < 2 * I_G) { const int up = r / I_G; r %= I_G; const int nb = r % 8, kb = r / 8; const int j = 32 * nb;
            transpose_item((up ? a.w_up : a.w_gate) + (size_t)e * 1024 * 256, 256, 64 * kb, j, a.WguT, 1024, 512 * e + 256 * (j >> 7) + 128 * up + (j & 127), nullptr, scr, F.lane); }
        else { r -= 2 * I_G; const int nb = r % 32, kb = r / 32; transpose_item(a.w_down + (size_t)e * 256 * 1024, 1024, 64 * kb, 32 * nb, a.WdT, 256, 1024 * e + 32 * nb, nullptr, scr, F.lane); }
    }
}
namespace mla {
constexpr int NW = 8, QBLK = 32, KVBLK = 64, KPITCH = 208;
constexpr int SHM_V = KVBLK * 64 * 2, SHM_K = KVBLK * KPITCH;
constexpr int LDS_V = 0, LDS_K = 2 * SHM_V, LDS_WS = LDS_K + 2 * SHM_K, LDS_BYTES = LDS_WS + NW * 64 * 4;
constexpr float THR = 6.0f;
__device__ __forceinline__ int crow(int r, int hi) { return (r & 3) + 8 * (r >> 2) + 4 * hi; }
__device__ __forceinline__ int v_st(int k, int c) { const int kk = (k & ~0xC) | ((k & 4) << 1) | ((k & 8) >> 1); return ((kk >> 3) * 2 + (c >> 5)) * 512 + ((kk & 7) * 32 + (c & 31)) * 2; }
__device__ __forceinline__ int v_rd_base(int lane) { return ((lane & 3) << 3) | (((lane >> 2) & 3) << 6) | (((lane >> 4) & 1) << 5) | (((lane >> 5) & 1) << 8); }
constexpr int v_rd_off(int d0, int ks, int half) { return d0 * 512 + ks * 2048 + half * 1024; }
template <int OFF> __device__ __forceinline__ s16x4 tr_read(int vb) { s16x4 r; asm volatile("ds_read_b64_tr_b16 %0, %1 offset:%2" : "=&v"(r) : "v"(vb), "i"(OFF) : "memory"); return r; }
template <int D0> __device__ __forceinline__ void pv_one(f32x16& od, int vb, bf16x8 pa0, bf16x8 pa1, bf16x8 pa2, bf16x8 pa3) {
    const s16x4 l0 = tr_read<v_rd_off(D0, 0, 0)>(vb), h0 = tr_read<v_rd_off(D0, 0, 1)>(vb), l1 = tr_read<v_rd_off(D0, 1, 0)>(vb), h1 = tr_read<v_rd_off(D0, 1, 1)>(vb);
    const s16x4 l2 = tr_read<v_rd_off(D0, 2, 0)>(vb), h2 = tr_read<v_rd_off(D0, 2, 1)>(vb), l3 = tr_read<v_rd_off(D0, 3, 0)>(vb), h3 = tr_read<v_rd_off(D0, 3, 1)>(vb);
    asm volatile("s_waitcnt lgkmcnt(0)" ::: "memory"); SBAR();
#define PK(L, H) (bf16x8){L[0], L[1], L[2], L[3], H[0], H[1], H[2], H[3]}
    od = __builtin_amdgcn_mfma_f32_32x32x16_bf16(pa0, PK(l0, h0), od, 0, 0, 0);
    od = __builtin_amdgcn_mfma_f32_32x32x16_bf16(pa1, PK(l1, h1), od, 0, 0, 0);
    od = __builtin_amdgcn_mfma_f32_32x32x16_bf16(pa2, PK(l2, h2), od, 0, 0, 0);
    od = __builtin_amdgcn_mfma_f32_32x32x16_bf16(pa3, PK(l3, h3), od, 0, 0, 0);
#undef PK
}
__device__ __forceinline__ void partialSM(f32x16& p0, f32x16& p1, float& m_reg, float& alpha) {
    float pmax = p0[0];
#pragma unroll
    for (int r = 1; r < 16; ++r) pmax = fmaxf(pmax, p0[r]);
#pragma unroll
    for (int r = 0; r < 16; ++r) pmax = fmaxf(pmax, p1[r]);
    { auto rr = __builtin_amdgcn_permlane32_swap(__float_as_uint(pmax), __float_as_uint(pmax), false, false); pmax = fmaxf(__uint_as_float(rr[0]), __uint_as_float(rr[1])); }
    float mn;
    if (__builtin_expect(__all(pmax - m_reg <= THR), 1)) { mn = m_reg; alpha = 1.f; }
    else { mn = fmaxf(m_reg, pmax); alpha = __builtin_amdgcn_exp2f(m_reg - mn); m_reg = mn; }
#pragma unroll
    for (int r = 0; r < 16; ++r) { p0[r] = p0[r] - mn; p1[r] = p1[r] - mn; }
#pragma unroll
    for (int r = 0; r < 16; ++r) p0[r] = __builtin_amdgcn_exp2f(p0[r]);
}
__device__ __forceinline__ void finishSM(f32x16& p0, f32x16& p1, float alpha, float& l_reg, bf16x8& pa0, bf16x8& pa1, bf16x8& pa2, bf16x8& pa3) {
#pragma unroll
    for (int r = 0; r < 16; ++r) p1[r] = __builtin_amdgcn_exp2f(p1[r]);
    float ps = 0;
#pragma unroll
    for (int r = 0; r < 16; ++r) ps += p0[r];
#pragma unroll
    for (int r = 0; r < 16; ++r) ps += p1[r];
    { auto rr = __builtin_amdgcn_permlane32_swap(__float_as_uint(ps), __float_as_uint(ps), false, false); ps = __uint_as_float(rr[0]) + __uint_as_float(rr[1]); }
    l_reg = l_reg * alpha + ps;
#define PK4(P, BASE, OUT) do { unsigned a0 = cvt_pk_bf16(P[BASE + 0], P[BASE + 1]), a1 = cvt_pk_bf16(P[BASE + 2], P[BASE + 3]);   \
    unsigned b0 = cvt_pk_bf16(P[BASE + 4], P[BASE + 5]), b1 = cvt_pk_bf16(P[BASE + 6], P[BASE + 7]);                              \
    auto r0 = __builtin_amdgcn_permlane32_swap(a0, b0, false, false); auto r1 = __builtin_amdgcn_permlane32_swap(a1, b1, false, false); \
    u32x4 w = {r0[0], r1[0], r0[1], r1[1]}; OUT = __builtin_bit_cast(bf16x8, w); } while (0)
    PK4(p0, 0, pa0); PK4(p0, 8, pa1); PK4(p1, 0, pa2); PK4(p1, 8, pa3);
#undef PK4
}
__device__ __forceinline__ void qkt(f32x16& p0, f32x16& p1, const char* Ks, const bf16x8* qr, int r32, int hi) {
    p0 = f32x16{}; p1 = f32x16{};
#pragma unroll
    for (int d0 = 0; d0 < 6; ++d0) { const int cb = (d0 * 16 + hi * 8) * 2;
        const bf16x8 b0 = *reinterpret_cast<const bf16x8*>(Ks + r32 * KPITCH + cb);
        const bf16x8 b1 = *reinterpret_cast<const bf16x8*>(Ks + (32 + r32) * KPITCH + cb);
        p0 = __builtin_amdgcn_mfma_f32_32x32x16_bf16(b0, qr[d0], p0, 0, 0, 0);
        p1 = __builtin_amdgcn_mfma_f32_32x32x16_bf16(b1, qr[d0], p1, 0, 0, 0); }
}
__device__ __forceinline__ void cmask(f32x16& p0, f32x16& p1, int jb, int qrel, int hi) {
    const float NEG = -INFINITY; int lim = qrel - 64 * jb - 4 * hi; asm volatile("" : "+v"(lim));
#pragma unroll
    for (int r = 0; r < 16; ++r) { const int kv = (r & 3) + 8 * (r >> 2); if (kv > lim) p0[r] = NEG; if (kv + 32 > lim) p1[r] = NEG; }
}

__device__ __forceinline__ void mla_unit(int b, int h, int qb, bf16_t* Qm, const bf16_t* __restrict__ KM, const bf16_t* __restrict__ VM, const float* __restrict__ cs, const float* __restrict__ sn,
                                         const float* __restrict__ gq, char* lds, bool dry) {
    int tid_ = threadIdx.x; asm volatile("" : "+v"(tid_));
    const int tid = tid_, wid = __builtin_amdgcn_readfirstlane(tid >> 6), lane = tid & 63, r32 = lane & 31, hi = lane >> 5;
    char* V_lds = lds + LDS_V; char* K_lds = lds + LDS_K;
    float* ws = (float*)(lds + LDS_WS) + wid * 64; float* li_l = ws; float* al_l = ws + 32;
    const long rowbase = (long)b * SEQ; const int q0 = qb * 256;
    const bf16_t* Kh = KM + rowbase * LD_KM + h * 96; const bf16_t* Vh = VM + rowbase * LD_VM + h * 64;
    float m_reg = -1e30f, l_reg = 0; f32x16 o[2] = {}; bf16x8 qr[6];
    {
        const long trow = rowbase + q0 + wid * QBLK + r32;
        const bf16_t* qp = Qm + trow * LD_QM + h * 96 + hi * 8;
        float qf[6][8]; float ss = 0.f;
#pragma unroll
        for (int d0 = 0; d0 < 6; ++d0) { unpack8(*(const u32x4*)(qp + d0 * 16), qf[d0]);
#pragma unroll
            for (int j = 0; j < 8; ++j) ss += qf[d0][j] * qf[d0][j]; }
        ss += __shfl_xor(ss, 32);
        const float sc = QS_MLA / sqrtf(ss * (1.0f / 96.0f) + EPS);
#pragma unroll
        for (int d0 = 0; d0 < 6; ++d0)
#pragma unroll
            for (int j = 0; j < 8; ++j) qf[d0][j] *= sc * gq[d0 * 16 + hi * 8 + j];
#pragma unroll
        for (int j = 0; j < 8; ++j) { const float c = cs[trow * 16 + hi * 8 + j], s = sn[trow * 16 + hi * 8 + j]; const float t1 = qf[4][j], t2 = qf[5][j];
            qf[4][j] = t1 * c - t2 * s; qf[5][j] = t2 * c + t1 * s; }
#pragma unroll
        for (int d0 = 0; d0 < 6; ++d0) qr[d0] = __builtin_bit_cast(bf16x8, pack8(qf[d0]));
    }
    const int sr = tid >> 3, sc8 = (tid & 7) * 8, sr2 = (tid >> 2) & 63, sc2 = 64 + (tid & 3) * 8;
    const int vst = v_st(sr, sc8);
    const int vb0 = (int)(uintptr_t)V_lds + v_rd_base(lane);
    const bool two = wid < 4;
    bf16x8 st_v0, st_k0, st_k1 = {};
#define SLOAD(kk0) do { st_v0 = *(const bf16x8*)(Vh + (long)((kk0) + sr) * LD_VM + sc8); st_k0 = *(const bf16x8*)(Kh + (long)((kk0) + sr) * LD_KM + sc8); \
    if (two) st_k1 = *(const bf16x8*)(Kh + (long)((kk0) + sr2) * LD_KM + sc2); } while (0)
#define SWRITE(bb) do { *(bf16x8*)(V_lds + (bb) * SHM_V + vst) = st_v0; *(bf16x8*)(K_lds + (bb) * SHM_K + sr * KPITCH + sc8 * 2) = st_k0; \
    if (two) *(bf16x8*)(K_lds + (bb) * SHM_K + sr2 * KPITCH + sc2 * 2) = st_k1; } while (0)
#define RESC(a) do { if (__any((a) < 1.f)) { if (hi == 0) al_l[r32] = (a); asm volatile("s_waitcnt lgkmcnt(0)" ::: "memory"); \
    _Pragma("unroll") for (int d = 0; d < 2; ++d) _Pragma("unroll") for (int r = 0; r < 16; ++r) o[d][r] *= al_l[crow(r, hi)]; } } while (0)
    f32x16 pA0, pA1, pB0, pB1; float alA, alB; bf16x8 pa0, pa1, pa2, pa3;
    const int NT = 4 * (qb + 1);
    const int qrel = wid * QBLK + r32;
#define CMASK(P0, P1, t) do { const int jb_ = (t) - (NT - 4); if (jb_ >= 0) cmask(P0, P1, jb_, qrel, hi); } while (0)
    __syncthreads();
    SLOAD(0); SWRITE(0); __syncthreads();
    qkt(pA0, pA1, K_lds, qr, r32, hi); CMASK(pA0, pA1, 0); partialSM(pA0, pA1, m_reg, alA);
    SLOAD(KVBLK); SWRITE(1); __syncthreads();
#pragma unroll 1
    for (int j = 1; j + 1 < NT; j += 2) {
        SBAR(); qkt(pB0, pB1, K_lds + SHM_K, qr, r32, hi); CMASK(pB0, pB1, j);
        finishSM(pA0, pA1, alA, l_reg, pa0, pa1, pa2, pa3); SBAR();
        SLOAD((j + 1) * KVBLK); SBAR();
        pv_one<0>(o[0], vb0, pa0, pa1, pa2, pa3); pv_one<1>(o[1], vb0, pa0, pa1, pa2, pa3); partialSM(pB0, pB1, m_reg, alB);
        __syncthreads(); SWRITE(0);
        RESC(alB); __syncthreads();
        SBAR(); qkt(pA0, pA1, K_lds, qr, r32, hi); CMASK(pA0, pA1, j + 1);
        finishSM(pB0, pB1, alB, l_reg, pa0, pa1, pa2, pa3); SBAR();
        SLOAD((j + 2) * KVBLK); SBAR();
        pv_one<0>(o[0], vb0 + SHM_V, pa0, pa1, pa2, pa3); pv_one<1>(o[1], vb0 + SHM_V, pa0, pa1, pa2, pa3); partialSM(pA0, pA1, m_reg, alA);
        __syncthreads(); SWRITE(1);
        RESC(alA); __syncthreads();
    }
    SBAR(); qkt(pB0, pB1, K_lds + SHM_K, qr, r32, hi); CMASK(pB0, pB1, NT - 1);
    finishSM(pA0, pA1, alA, l_reg, pa0, pa1, pa2, pa3); SBAR();
    pv_one<0>(o[0], vb0, pa0, pa1, pa2, pa3); pv_one<1>(o[1], vb0, pa0, pa1, pa2, pa3); partialSM(pB0, pB1, m_reg, alB);
    RESC(alB);
    finishSM(pB0, pB1, alB, l_reg, pa0, pa1, pa2, pa3); SBAR();
    pv_one<0>(o[0], vb0 + SHM_V, pa0, pa1, pa2, pa3); pv_one<1>(o[1], vb0 + SHM_V, pa0, pa1, pa2, pa3);
    if (hi == 0) li_l[r32] = l_reg; asm volatile("s_waitcnt lgkmcnt(0)" ::: "memory");
    bf16_t* Ow = Qm + (rowbase + q0 + wid * QBLK) * LD_QM + h * 96;
#pragma unroll
    for (int r = 0; r < 16; ++r) { const int orow = crow(r, hi); const float rl = __builtin_amdgcn_rcpf(li_l[orow]);
#pragma unroll
        for (int d0 = 0; d0 < 2; ++d0) { const unsigned w = cvt_pk_bf16(o[d0][r] * rl, 0.f); if (!dry) Ow[(long)orow * LD_QM + d0 * 32 + r32] = (bf16_t)(w & 0xffffu); } }
#undef SLOAD
#undef SWRITE
#undef RESC
#undef CMASK
}
}
namespace dil {
using mla::crow;
constexpr int KPITCH = 144;
constexpr int OPITCH = 68;
constexpr int LDS_O = 0, LDS_M = 256 * OPITCH * 4, LDS_L = LDS_M + 1024, LDS_KW = LDS_L + 1024, LDS_VW = LDS_KW + 8 * 32 * KPITCH, LDS_BYTES = LDS_VW + 8 * 4096;
static_assert(LDS_BYTES <= LDSCTL_OFF, "dilated attention LDS");
template <int G> __device__ __forceinline__ int tq_of(int wid, int q, int c8) {
    if constexpr (G == 0) return 256 * c8 + 32 * wid + q;
    else if constexpr (G == 1) return 4 * (64 * c8 + 32 * (wid >> 2) + q) + (wid & 3);
    else return 16 * (16 * c8 + (q & 15)) + 2 * wid + (q >> 4);
}
template <int G> __device__ __forceinline__ int tk_of(int wid, int kk, int kt, int c8) {
    if constexpr (G == 0) return 256 * c8 + 32 * wid - 128 + 32 * kt + kk;
    else if constexpr (G == 1) return 4 * (64 * c8 + 32 * (wid >> 2) - 128 + 32 * kt + kk) + (wid & 3);
    else return 16 * (16 * kt + (kk & 15)) + 2 * wid + (kk >> 4);
}
template <int G> __device__ __forceinline__ int ti_of(int wid, int q) {
    if constexpr (G == 0) return 32 * wid + q;
    else if constexpr (G == 1) return 128 * (wid >> 2) + 4 * q + (wid & 3);
    else return 16 * (q & 15) + 2 * wid + (q >> 4);
}
template <int OFF> __device__ __forceinline__ s16x4 trr(int vb) { s16x4 r; asm volatile("ds_read_b64_tr_b16 %0, %1 offset:%2" : "=&v"(r) : "v"(vb), "i"(OFF) : "memory"); return r; }
template <int S> __device__ __forceinline__ bf16x8 pack_step(const f32x16& x) {
    u32x4 w; w.x = cvt_pk_bf16(x[8 * S + 0], x[8 * S + 1]); w.y = cvt_pk_bf16(x[8 * S + 2], x[8 * S + 3]); w.z = cvt_pk_bf16(x[8 * S + 4], x[8 * S + 5]); w.w = cvt_pk_bf16(x[8 * S + 6], x[8 * S + 7]);
    return __builtin_bit_cast(bf16x8, w);
}

template <int G> __device__ __forceinline__ void dil_pass(int b, int h, int c8, bf16_t* DQ, const bf16_t* __restrict__ DK, const bf16_t* __restrict__ DV, char* lds, float slope2, bool dry) {
    constexpr int DIL = (G == 0) ? 1 : (G == 1) ? 4 : 16;
    int tid_ = threadIdx.x; asm volatile("" : "+v"(tid_));
    const int tid = tid_, wid = __builtin_amdgcn_readfirstlane(tid >> 6), lane = tid & 63, q = lane & 31, hi = lane >> 5;
    float* OST = (float*)(lds + LDS_O); float* MST = (float*)(lds + LDS_M); float* LST = (float*)(lds + LDS_L);
    char* Kw = lds + LDS_KW + wid * (32 * KPITCH); char* Vw = lds + LDS_VW + wid * 4096;
    const int vb = (int)(uintptr_t)Vw + ((lane & 3) << 3) + (((lane >> 2) & 3) << 6) + (((lane >> 4) & 1) << 5) + (hi << 8);
    const long seqbase = (long)b * SEQ;
    const int tq = tq_of<G>(wid, q, c8);
    bf16x8 qr[4];
    { const bf16_t* qp = DQ + (seqbase + tq) * LD_DIL + G * 512 + h * 64 + hi * 8;
#pragma unroll
      for (int d0 = 0; d0 < 4; ++d0) qr[d0] = *(const bf16x8*)(qp + 16 * d0); }
    float m = -1e30f, l = 0.f; f32x16 ot[2] = {};
    int kt0, nkt;
    if constexpr (G == 0) { const int u0 = 256 * c8 + 32 * wid; kt0 = u0 >= 128 ? 0 : (128 - u0) >> 5; nkt = 5; }
    else if constexpr (G == 1) { const int u0 = 64 * c8 + 32 * (wid >> 2); kt0 = u0 >= 128 ? 0 : (128 - u0) >> 5; nkt = 5; }
    else { kt0 = 0; nkt = c8 + 1; }
    kt0 = __builtin_amdgcn_readfirstlane(kt0);
    const float SL = slope2 * (float)DIL;
    const int r8 = lane >> 3, ch = lane & 7;
    const size_t coff = (size_t)G * 512 + h * 64 + ch * 8;
    const int kst = r8 * KPITCH + ch * 16, vst = (ch >> 2) * 512 + (r8 * 32 + 8 * (ch & 3)) * 2;
    const char* kfp = Kw + q * KPITCH + hi * 16;
    bf16x8 kst_[4], vst_[4];
#define DIL_LOAD(KT) do { _Pragma("unroll") for (int i = 0; i < 4; ++i) { const size_t ro_ = (size_t)(seqbase + tk_of<G>(wid, 8 * i + r8, (KT), c8)) * LD_DIL + coff; \
        kst_[i] = *(const bf16x8*)(DK + ro_); vst_[i] = *(const bf16x8*)(DV + ro_); } } while (0)
    DIL_LOAD(kt0);
#pragma unroll 1
    for (int kt = kt0; kt < nkt; ++kt) {
#pragma unroll
        for (int i = 0; i < 4; ++i) { *(bf16x8*)(Kw + i * 8 * KPITCH + kst) = kst_[i]; *(bf16x8*)(Vw + i * 1024 + vst) = vst_[i]; }
        if (kt + 1 < nkt) DIL_LOAD(kt + 1);
        f32x16 p = {};
        { bf16x8 kf[4];
#pragma unroll
          for (int d0 = 0; d0 < 4; ++d0) kf[d0] = *(const bf16x8*)(kfp + d0 * 32);
#pragma unroll
          for (int d0 = 0; d0 < 4; ++d0) p = __builtin_amdgcn_mfma_f32_32x32x16_bf16(kf[d0], qr[d0], p, 0, 0, 0); }
        if constexpr (G < 2) {
            const float B = SL * (float)(4 * hi - q - 128 + 32 * kt);
#pragma unroll
            for (int r = 0; r < 16; ++r) p[r] = fmaf(SL, (float)((r & 3) + 8 * (r >> 2)), p[r] + B);
            if (kt == 0) {
                int lim = q - 4 * hi; asm volatile("" : "+v"(lim));
#pragma unroll
                for (int r = 0; r < 16; ++r) if ((r & 3) + 8 * (r >> 2) < lim) p[r] = -INFINITY;
            } else if (kt == 4) {
                int lim = q - 4 * hi; asm volatile("" : "+v"(lim));
#pragma unroll
                for (int r = 0; r < 16; ++r) if ((r & 3) + 8 * (r >> 2) > lim) p[r] = -INFINITY;
            }
        } else {
            const float B = -SL * (float)(16 * (c8 - kt) + (q & 15) - 4 * hi);
            const float Blo = (q < 16) ? B : -INFINITY, Bhi = (q < 16) ? -INFINITY : B;
#pragma unroll
            for (int r = 0; r < 16; ++r) p[r] = fmaf(SL, (float)(((r & 3) + 8 * (r >> 2)) & 15), p[r] + (r < 8 ? Blo : Bhi));
            if (kt == c8) {
                int lim = (q & 15) - 4 * hi; asm volatile("" : "+v"(lim));
#pragma unroll
                for (int r = 0; r < 16; ++r) if ((((r & 3) + 8 * (r >> 2)) & 15) > lim) p[r] = -INFINITY;
            }
        }
        float pmax = p[0];
#pragma unroll
        for (int r = 1; r < 16; ++r) pmax = fmaxf(pmax, p[r]);
        { auto rr = __builtin_amdgcn_permlane32_swap(__float_as_uint(pmax), __float_as_uint(pmax), false, false); pmax = fmaxf(__uint_as_float(rr[0]), __uint_as_float(rr[1])); }
        const float mn = fmaxf(m, pmax), alpha = __builtin_amdgcn_exp2f(m - mn); m = mn;
        float ps = 0.f;
#pragma unroll
        for (int r = 0; r < 16; ++r) { p[r] = __builtin_amdgcn_exp2f(p[r] - mn); ps += p[r]; }
        { auto rr = __builtin_amdgcn_permlane32_swap(__float_as_uint(ps), __float_as_uint(ps), false, false); ps = __uint_as_float(rr[0]) + __uint_as_float(rr[1]); }
        l = l * alpha + ps;
        if (__any(alpha < 1.f)) {
#pragma unroll
            for (int d = 0; d < 2; ++d)
#pragma unroll
                for (int r = 0; r < 16; ++r) ot[d][r] *= alpha; }
        const bf16x8 pb0 = pack_step<0>(p), pb1 = pack_step<1>(p);
        {
            const s16x4 a00 = trr<0>(vb), a01 = trr<1024>(vb), a10 = trr<2048>(vb), a11 = trr<3072>(vb);
            const s16x4 b00 = trr<512>(vb), b01 = trr<1536>(vb), b10 = trr<2560>(vb), b11 = trr<3584>(vb);
            asm volatile("s_waitcnt lgkmcnt(0)" ::: "memory"); SBAR();
#define PK(L, H) (bf16x8){L[0], L[1], L[2], L[3], H[0], H[1], H[2], H[3]}
            ot[0] = __builtin_amdgcn_mfma_f32_32x32x16_bf16(PK(a00, a01), pb0, ot[0], 0, 0, 0);
            ot[0] = __builtin_amdgcn_mfma_f32_32x32x16_bf16(PK(a10, a11), pb1, ot[0], 0, 0, 0);
            ot[1] = __builtin_amdgcn_mfma_f32_32x32x16_bf16(PK(b00, b01), pb0, ot[1], 0, 0, 0);
            ot[1] = __builtin_amdgcn_mfma_f32_32x32x16_bf16(PK(b10, b11), pb1, ot[1], 0, 0, 0);
#undef PK
        }
    }
#undef DIL_LOAD
    const int ti = ti_of<G>(wid, q);
    float* orow = OST + ti * OPITCH + 4 * hi;
    if constexpr (G == 0) {
        if (hi == 0) { MST[ti] = m; LST[ti] = l; }
#pragma unroll
        for (int d0 = 0; d0 < 2; ++d0)
#pragma unroll
            for (int g4 = 0; g4 < 4; ++g4) *(f32x4*)(orow + 32 * d0 + 8 * g4) = (f32x4){ot[d0][4 * g4], ot[d0][4 * g4 + 1], ot[d0][4 * g4 + 2], ot[d0][4 * g4 + 3]};
    } else {
        const float Mo = MST[ti], Lo = LST[ti]; const float mnew = fmaxf(Mo, m); const float a = __builtin_amdgcn_exp2f(Mo - mnew), bb = __builtin_amdgcn_exp2f(m - mnew); const float Ln = a * Lo + bb * l;
        asm volatile("s_waitcnt lgkmcnt(0)" ::: "memory");
        if (hi == 0) { MST[ti] = mnew; LST[ti] = Ln; }
        const float inv = 1.0f / Ln;
        bf16_t* Ob = DQ + (seqbase + 256 * c8 + ti) * LD_DIL + h * 64 + 4 * hi;
#pragma unroll
        for (int d0 = 0; d0 < 2; ++d0)
#pragma unroll
            for (int g4 = 0; g4 < 4; ++g4) { const f32x4 old = *(const f32x4*)(orow + 32 * d0 + 8 * g4); f32x4 v;
#pragma unroll
                for (int j = 0; j < 4; ++j) v[j] = a * old[j] + bb * ot[d0][4 * g4 + j];
                if constexpr (G == 2) { u32x2 w; w.x = cvt_pk_bf16(v[0] * inv, v[1] * inv); w.y = cvt_pk_bf16(v[2] * inv, v[3] * inv); if (!dry) *(u32x2*)(Ob + 32 * d0 + 8 * g4) = w; }
                else *(f32x4*)(orow + 32 * d0 + 8 * g4) = v; }
    }
}
__device__ __forceinline__ void dil_unit(int b, int h, int c8, bf16_t* DQ, const bf16_t* DK, const bf16_t* DV, char* lds, bool dry) {
    const float slope2 = exp2f(-(float)(h + 1)) * LOG2E;
    __syncthreads();
    dil_pass<0>(b, h, c8, DQ, DK, DV, lds, slope2, dry);
    __syncthreads();
    dil_pass<1>(b, h, c8, DQ, DK, DV, lds, slope2, dry);
    __syncthreads();
    dil_pass<2>(b, h, c8, DQ, DK, DV, lds, slope2, dry);
}
}
struct P6bArgs { const float *x1, *norm_ffn, *w_rg, *b_rg, *w_re, *b_re; bf16_t* H2; unsigned* tinfo; int* list; gu32* cnt; };
__device__ __forceinline__ void p6_route(Frame& F, const P6bArgs& a) {
    LAS float* Wr = (LAS float*)(F.lds);
    volatile LAS unsigned* lcnt = F.MISC + 16;
    for (int idx = F.tid; idx < 1024 * 36; idx += NWAVES * 64) { const int k = idx / 36, c = idx - k * 36; Wr[idx] = c < 32 ? a.w_re[k * 32 + c] : a.w_rg[k * 4 + (c - 32)]; }
    if (F.tid < 32) lcnt[F.tid] = 0u;
    __syncthreads();
    const int gw = F.vcu * NWAVES + F.wave, NGW = F.G * NWAVES, lane = F.lane;
    float gf[16];
#pragma unroll
    for (int i = 0; i < 16; ++i) gf[i] = a.norm_ffn[lane + 64 * i];
    int s_t = -1, s_e0 = 0, s_e1 = 0; float s_w0 = 0.f, s_w1 = 0.f;
    int it = 0;
    for (int t = gw; t < T_TOK; t += NGW, ++it) {
        const float* xr = a.x1 + (size_t)t * D_MODEL + lane;
        float hx[16]; float ss = 0.f;
#pragma unroll
        for (int i = 0; i < 16; ++i) { hx[i] = xr[64 * i]; ss += hx[i] * hx[i]; }
        const float rstd = 1.f / sqrtf(wave_sum(ss) * (1.f / D_MODEL) + EPS);
        bf16_t* hp = a.H2 + (size_t)t * D_MODEL + lane;
#pragma unroll
        for (int i = 0; i < 16; ++i) { hx[i] = hx[i] * rstd * gf[i]; hp[64 * i] = (bf16_t)(cvt_pk_bf16(hx[i], 0.f) & 0xffffu); }
        float lg[4] = {0.f, 0.f, 0.f, 0.f};
#pragma unroll
        for (int i = 0; i < 16; ++i) { const f32x4 w = *(const LAS f32x4*)(Wr + (lane + 64 * i) * 36 + 32); lg[0] += hx[i] * w[0]; lg[1] += hx[i] * w[1]; lg[2] += hx[i] * w[2]; lg[3] += hx[i] * w[3]; }
#pragma unroll
        for (int c = 0; c < 4; ++c) lg[c] = wave_sum(lg[c]) + a.b_rg[c];
        int gi = 0; float gm = lg[0];
#pragma unroll
        for (int c = 1; c < 4; ++c) if (lg[c] > gm) { gm = lg[c]; gi = c; }
        float gden = 0.f;
#pragma unroll
        for (int c = 0; c < 4; ++c) gden += __expf(lg[c] - gm);
        const float g_p = 1.0f / gden;
        float le[8] = {0.f, 0.f, 0.f, 0.f, 0.f, 0.f, 0.f, 0.f};
#pragma unroll
        for (int i = 0; i < 16; ++i) { const LAS float* wp = Wr + (lane + 64 * i) * 36 + 8 * gi; const f32x4 w0 = *(const LAS f32x4*)wp, w1 = *(const LAS f32x4*)(wp + 4);
#pragma unroll
            for (int j = 0; j < 4; ++j) { le[j] += hx[i] * w0[j]; le[4 + j] += hx[i] * w1[j]; } }
#pragma unroll
        for (int j = 0; j < 8; ++j) le[j] = wave_sum(le[j]) + a.b_re[8 * gi + j];
        int e0 = 0; float m0 = le[0];
#pragma unroll
        for (int j = 1; j < 8; ++j) if (le[j] > m0) { m0 = le[j]; e0 = j; }
        int e1 = -1; float m1 = -INFINITY;
#pragma unroll
        for (int j = 0; j < 8; ++j) if (j != e0 && le[j] > m1) { m1 = le[j]; e1 = j; }
        const float p1 = __expf(m1 - m0);
        const float w0 = g_p / (1.0f + p1), w1 = g_p * p1 / (1.0f + p1);
        if (lane == it) { s_t = t; s_e0 = 8 * gi + e0; s_e1 = 8 * gi + e1; s_w0 = w0; s_w1 = w1; }
    }
    unsigned lp0 = 0u, lp1 = 0u;
    if (s_t >= 0) { lp0 = __hip_atomic_fetch_add((LAS unsigned*)&lcnt[s_e0], 1u, __ATOMIC_RELAXED, __HIP_MEMORY_SCOPE_WORKGROUP); lp1 = __hip_atomic_fetch_add((LAS unsigned*)&lcnt[s_e1], 1u, __ATOMIC_RELAXED, __HIP_MEMORY_SCOPE_WORKGROUP); }
    __syncthreads();
    if (F.tid < 32) { const unsigned c = lcnt[F.tid]; const unsigned base = c ? __hip_atomic_fetch_add(a.cnt + 64 * F.tid, c, RLX_AGENT) : 0u; lcnt[F.tid] = base; }
    __syncthreads();
    if (s_t >= 0) {
        const unsigned p0 = lcnt[s_e0] + lp0, p1 = lcnt[s_e1] + lp1;
        a.list[(size_t)s_e0 * LIST_CAP + p0] = s_t; a.list[(size_t)s_e1 * LIST_CAP + p1] = s_t;
        u32x4 ti; ti.x = ((unsigned)s_e0 << 16) | p0; ti.y = ((unsigned)s_e1 << 16) | p1; ti.z = __float_as_uint(s_w0); ti.w = __float_as_uint(s_w1);
        *(u32x4*)(a.tinfo + (size_t)s_t * 4) = ti;
    }
}

struct MoeSched {
    const LAS int* tstart;
    const LAS int* cntl;
    const int* list;
    int nct, G, c, lda_bytes;
    __device__ __forceinline__ bool next(int i, pg8::Unit& u) const {
        const int L = i * G + c, total = tstart[32] * nct; if (L >= total) return false;
        const int rt = L / nct, pnl = L - rt * nct; int e = 0;
        for (int j = 1; j < 32; ++j) e = (tstart[j] <= rt) ? j : e;
        u.pm = rt; u.pn = e * nct + pnl; u.aux = e; return true;
    }
    __device__ __forceinline__ unsigned row_off(const pg8::Unit& u, int row) const {
        const int e = u.aux, pos = (u.pm - tstart[e]) * 256 + row; const int tok = list[(size_t)e * LIST_CAP + (pos < cntl[e] ? pos : 0)];
        return (unsigned)tok * (unsigned)lda_bytes;
    }
};
__device__ __forceinline__ void moe_tables(Frame& F, const gu32* cnt) {
    LAS int* tstart = (LAS int*)(F.lds + TAB_OFF); LAS int* cntl = tstart + 64;
    __syncthreads();
    if (F.tid == 0) { int acc = 0; for (int e = 0; e < 32; ++e) { const int c = (int)__hip_atomic_load(cnt + 64 * e, RLX_AGENT); cntl[e] = c; tstart[e] = acc; acc += (c + 255) >> 8; } tstart[32] = acc; }
    __syncthreads();
}

__device__ __forceinline__ void p9_combine(Frame& F, float* out, const bf16_t* Y, const unsigned* tinfo) {
    const LAS int* tstart = (const LAS int*)(F.lds + TAB_OFF);
    const int gw = F.vcu * NWAVES + F.wave, NGW = F.G * NWAVES;
    for (int t = gw; t < T_TOK; t += NGW) {
        const u32x4 ti = *(const u32x4*)(tinfo + (size_t)t * 4);
        const int e0 = ti.x >> 16, e1 = ti.y >> 16; const size_t s0 = (size_t)tstart[e0] * 256 + (ti.x & 0xffffu), s1 = (size_t)tstart[e1] * 256 + (ti.y & 0xffffu);
        const float w0 = __uint_as_float(ti.z), w1 = __uint_as_float(ti.w);
        GAS f32x4* xr = (GAS f32x4*)(out + (size_t)t * D_MODEL) + F.lane;
        const GAS u32x2* y0 = (const GAS u32x2*)(Y + s0 * D_MODEL) + F.lane; const GAS u32x2* y1 = (const GAS u32x2*)(Y + s1 * D_MODEL) + F.lane;
#pragma unroll
        for (int j = 0; j < 4; ++j) { f32x4 v = xr[64 * j]; const u32x2 a = y0[64 * j], b = y1[64 * j];
            v.x += w0 * bflo(a.x) + w1 * bflo(b.x); v.y += w0 * bfhi(a.x) + w1 * bfhi(b.x); v.z += w0 * bflo(a.y) + w1 * bflo(b.y); v.w += w0 * bfhi(a.y) + w1 * bfhi(b.y);
            xr[64 * j] = v; }
    }
}
#ifndef MK_N_LAUNCHES
#define MK_N_LAUNCHES 1
#endif
#ifndef PHASE_REPEAT_MASK
#define PHASE_REPEAT_MASK 0
#endif
#ifndef PROBE_PAD
#define PROBE_PAD 0
#endif
constexpr int N_LAUNCHES = MK_N_LAUNCHES;
constexpr int NPHASE = 11;
struct Args { const float* in[22]; const int* positions; float* out; unsigned char* ws; int ph_lo, ph_hi, li, pad; };

__global__ void __launch_bounds__(NWAVES * 64, 2) fwd_kernel(Args args) {
    extern __shared__ __attribute__((aligned(16))) unsigned char lds[];
    Frame F;
    F.lds = (LAS unsigned char*)lds;
    F.MISC = (volatile LAS unsigned*)(F.lds + MISC_OFF);
    F.tid = threadIdx.x; F.lane = F.tid & 63; F.wave = __builtin_amdgcn_readfirstlane(F.tid >> 6);
    F.G = gridDim.x; { const int bx = blockIdx.x; F.vcu = (F.G % 8 == 0) ? (bx % 8) * (F.G / 8) + bx / 8 : bx; }
    F.ctl = (gu32*)(args.ws + WS_CTL);
    for (int u = F.tid; u < (LDS_BYTES - LDSCTL_OFF) / 4; u += NWAVES * 64) ((LAS unsigned*)(F.lds + LDSCTL_OFF))[u] = 0u;
    __syncthreads();
    XcdBarrier bar; bar.bar = (unsigned*)(F.ctl + CW_BAR); bar.x = 0; bar.st = nullptr;
    if (N_LAUNCHES == 1) bar = xcd_barrier_post((unsigned*)(F.ctl + CW_BAR), F.MISC + 8);
#define GRID_BAR() do { if (N_LAUNCHES == 1) xcd_barrier(bar); } while (0)
    const int lo = args.ph_lo, hi = args.ph_hi;
#ifndef PHASE_MASK
#define PHASE_MASK 0x7ff
#endif
#define IN(k) ((((PHASE_MASK) >> (k)) & 1) && lo <= (k) && (k) < hi)
#ifndef PHASE_REPEAT_MASK
#define PHASE_REPEAT_MASK 0
#endif
#ifndef PROBE_PAD
#define PROBE_PAD 0
#endif
#define REP(k)
#define INP(i) (args.in[i])
#define WSP(T, off) ((T*)(wsb_ + (off)))
#define PHASE_BASE() unsigned char* wsb_ = args.ws; asm volatile("" : "+s"(wsb_))
    if (IN(0)) REP(0) { PHASE_BASE(); P0Args a{INP(0), INP(2), INP(3), INP(5), INP(6), INP(11), INP(12), INP(13), args.positions, WSP(bf16_t, WS_WIN), WSP(bf16_t, WS_WUKV), WSP(bf16_t, WS_WOM), WSP(bf16_t, WS_WOD), WSP(bf16_t, WS_WOUT), WSP(bf16_t, WS_B), WSP(float, WS_ROPE), WSP(float, WS_ROPE) + (size_t)T_TOK * 16}; p0_prologue(F, a); GRID_BAR(); }
    if (IN(1)) REP(1) {
        PHASE_BASE();
        pg8::Gemm g{WSP(bf16_t, WS_B), WSP(bf16_t, WS_WIN), 1024, 1024, 1024, 128}; pg8::StaticOrder S; S.init(T_TOK, N1_PAD, F.G, (int)blockIdx.x);
        #ifdef DBG_GATES_IN_WS
        pg8::Epi1 E{WSP(bf16_t, WS_QM), WSP(bf16_t, WS_CK), WSP(bf16_t, WS_DQ), WSP(bf16_t, WS_DQ), WSP(bf16_t, WS_DQ), WSP(bf16_t, WS_DK),
#else
        pg8::Epi1 E{WSP(bf16_t, WS_QM), WSP(bf16_t, WS_CK), WSP(bf16_t, WS_DQ), WSP(bf16_t, WS_DK), WSP(bf16_t, WS_DV), (bf16_t*)args.out,
#endif
 WSP(float, WS_CKS), INP(4), INP(9), INP(10)};
        pg8::gemm_phase<pg8::Epi1, pg8::StaticOrder, true, false>(F.lds + RING_OFF, g, S, E);
        GRID_BAR();
    }
    if (IN(2)) REP(2) {
        PHASE_BASE();
        pg8::Gemm g{WSP(bf16_t, WS_CK), WSP(bf16_t, WS_WUKV), LD_CK, 256, 256, 128}; pg8::StaticOrder S; S.init(T_TOK, 1024, F.G, (int)blockIdx.x);
        pg8::Epi2 E{WSP(bf16_t, WS_B), WSP(bf16_t, WS_VM), WSP(bf16_t, WS_CK), WSP(float, WS_CKS), INP(8), WSP(float, WS_ROPE), WSP(float, WS_ROPE) + (size_t)T_TOK * 16};
        pg8::gemm_phase<pg8::Epi2, pg8::StaticOrder, true, false>(F.lds + RING_OFF, g, S, E);
        GRID_BAR();
    }
    if (IN(3)) {
        const bool bal = (F.G == 256);
#ifndef NO_MLA
        { PHASE_BASE();
#pragma unroll 1
        for (int pass_ = (args.pad & 1) ? 0 : 1; pass_ < 2; ++pass_)
#pragma unroll 1
        for (int i = 0; ; ++i) {
            int b, h, qb;
            if (bal) { if (i >= 4) break; const int x = F.vcu >> 5, j = F.vcu & 31, bh = x * 16 + i * 4 + (j >> 3), pos = j & 7; b = bh >> 3; h = bh & 7; qb = (i & 1) ? 7 - pos : pos; }
            else { const int L = F.vcu + i * F.G; if (L >= 1024) break; const int bh = L >> 3; b = bh >> 3; h = bh & 7; qb = L & 7; }
            mla::mla_unit(b, h, qb, WSP(bf16_t, WS_QM), WSP(bf16_t, WS_B), WSP(bf16_t, WS_VM), WSP(float, WS_ROPE), WSP(float, WS_ROPE) + (size_t)T_TOK * 16, INP(7), (char*)lds + RING_OFF, pass_ == 0);
        } }
#endif
#ifndef NO_DIL
        { PHASE_BASE();
#pragma unroll 1
        for (int pass_ = (args.pad & 2) ? 0 : 1; pass_ < 2; ++pass_)
#pragma unroll 1
        for (int i = 0; ; ++i) {
            int b, h, c8;
            if (bal) { if (i >= 4) break; const int x = F.vcu >> 5, j = F.vcu & 31, bh = x * 16 + i * 4 + (j >> 3), pos = j & 7; b = bh >> 3; h = bh & 7; c8 = (i & 1) ? 7 - pos : pos; }
            else { const int L = F.vcu + i * F.G; if (L >= 1024) break; const int bh = L >> 3; b = bh >> 3; h = bh & 7; c8 = L & 7; }
            dil::dil_unit(b, h, c8, WSP(bf16_t, WS_DQ), WSP(bf16_t, WS_DK), WSP(bf16_t, WS_DV), (char*)lds + RING_OFF, pass_ == 0);
        } }
#endif
        __syncthreads();
        GRID_BAR();
    }
    if (IN(4)) REP(4) {
        PHASE_BASE();
        pg8::Gemm g{WSP(bf16_t, WS_QM), WSP(bf16_t, WS_WOM), LD_QM, 512, 512, 192}; pg8::StaticOrder S; S.init(T_TOK, 1024, F.G, (int)blockIdx.x);
        pg8::EpiPlain E{WSP(bf16_t, WS_B), 1024, 0xffff};
        pg8::gemm_phase<pg8::EpiPlain, pg8::StaticOrder, true, false>(F.lds + RING_OFF, g, S, E);
        GRID_BAR();
    }
    if (IN(5)) REP(5) {
        PHASE_BASE();
        pg8::Gemm g{WSP(bf16_t, WS_DQ), WSP(bf16_t, WS_WOD), LD_DIL, 512, 512, 128}; pg8::StaticOrder S; S.init(T_TOK, 1024, F.G, (int)blockIdx.x);
        pg8::EpiMerge E{WSP(bf16_t, WS_DV), WSP(bf16_t, WS_B), (const bf16_t*)args.out};
        pg8::gemm_phase<pg8::EpiMerge, pg8::StaticOrder, true, false>(F.lds + RING_OFF, g, S, E);
        GRID_BAR();
    }
    if (IN(6)) REP(6) {
        PHASE_BASE();
        pg8::Gemm g{WSP(bf16_t, WS_DV), WSP(bf16_t, WS_WOUT), 1024, 1024, 1024, 128}; pg8::StaticOrder S; S.init(T_TOK, 1024, F.G, (int)blockIdx.x);
        pg8::EpiResid E{INP(0), args.out};
        pg8::gemm_phase<pg8::EpiResid, pg8::StaticOrder, true, false>(F.lds + RING_OFF, g, S, E);
        GRID_BAR();
    }
    if (IN(7)) {
        PHASE_BASE();
        P6Args wa{INP(19), INP(20), INP(21), WSP(bf16_t, WS_VM), WSP(bf16_t, WS_CK)}; p6_weights(F, wa);
        __syncthreads();
        P6bArgs ra{args.out, INP(14), INP(15), INP(16), INP(17), INP(18), WSP(bf16_t, WS_B), WSP(unsigned, WS_TINFO), WSP(int, WS_LIST), F.ctl + CW_CNT}; p6_route(F, ra);
        __syncthreads();
        GRID_BAR();
    }
    if (IN(8)) REP(8) {
        PHASE_BASE();
        moe_tables(F, F.ctl + CW_CNT);
        MoeSched S{(const LAS int*)(F.lds + TAB_OFF), (const LAS int*)(F.lds + TAB_OFF) + 64, WSP(int, WS_LIST), 2, F.G, (int)blockIdx.x, 2048};
        pg8::Gemm g{WSP(bf16_t, WS_B), WSP(bf16_t, WS_VM), 1024, 1024, 1024, 128};
        pg8::EpiSwiglu E{WSP(bf16_t, WS_DV)};
        pg8::gemm_phase<pg8::EpiSwiglu, MoeSched, true, true>(F.lds + RING_OFF, g, S, E);
        GRID_BAR();
    }
    if (IN(9)) REP(9) {
        PHASE_BASE();
        moe_tables(F, F.ctl + CW_CNT);
        MoeSched S{(const LAS int*)(F.lds + TAB_OFF), (const LAS int*)(F.lds + TAB_OFF) + 64, WSP(int, WS_LIST), 4, F.G, (int)blockIdx.x, 0};
        pg8::Gemm g{WSP(bf16_t, WS_DV), WSP(bf16_t, WS_CK), 256, 256, 256, 128};
        pg8::EpiPlain E{WSP(bf16_t, WS_Y), 1024, 3};
        pg8::gemm_phase<pg8::EpiPlain, MoeSched, true, false>(F.lds + RING_OFF, g, S, E);
        GRID_BAR();
    }
    if (IN(10)) {
        PHASE_BASE();
        moe_tables(F, F.ctl + CW_CNT);
        p9_combine(F, args.out, WSP(bf16_t, WS_Y), WSP(unsigned, WS_TINFO));
    }
#ifdef DBG_DUMP_OFF
    if (args.li == N_LAUNCHES - 1) { PHASE_BASE();
        __syncthreads();
        const bf16_t* src = DBG_DUMP_OUT ? (const bf16_t*)args.out : WSP(const bf16_t, DBG_DUMP_OFF);
        float* tmp = WSP(float, DBG_TMP_OFF);
        const int gt = F.vcu * (NWAVES * 64) + F.tid, NGT = F.G * NWAVES * 64;
        for (size_t idx = gt; idx < (size_t)T_TOK * 1024; idx += NGT) { const size_t t = idx >> 10; const int c = (int)(idx & 1023) % DBG_DUMP_COLS; tmp[idx] = bf2f(src[t * DBG_DUMP_LD + c]); }
    }
#endif
#undef IN
#undef GRID_BAR
#undef INP
#undef WSP
#undef PHASE_BASE
}

extern "C" void kernel_launch(void* const* d_in, const int* in_sizes, int n_in, void* d_out, int out_size, void* d_ws, size_t ws_size, hipStream_t stream) {
    static int grid = 0;
    if (grid == 0) {
        if (n_in != 22 || in_sizes[0] != T_TOK * D_MODEL || out_size != T_TOK * D_MODEL || ws_size < WS_END) {
            fprintf(stderr, "kernel_launch: shape/workspace mismatch: n_in %d in0 %d out %d ws %zu (need >= %zu); nothing launched\n", n_in, n_in > 0 ? in_sizes[0] : -1, out_size, ws_size, (size_t)WS_END); grid = -1; return; }
        int dev = 0, cus = 0, per_cu = 0;
        if (hipGetDevice(&dev) != hipSuccess || hipDeviceGetAttribute(&cus, hipDeviceAttributeMultiprocessorCount, dev) != hipSuccess) { fprintf(stderr, "kernel_launch: device query failed\n"); grid = -1; return; }
        if (hipFuncSetAttribute((const void*)fwd_kernel, hipFuncAttributeMaxDynamicSharedMemorySize, LDS_BYTES) != hipSuccess) { fprintf(stderr, "kernel_launch: hipFuncSetAttribute failed\n"); grid = -1; return; }
        if (hipOccupancyMaxActiveBlocksPerMultiprocessor(&per_cu, (const void*)fwd_kernel, NWAVES * 64, LDS_BYTES) != hipSuccess || per_cu < 1)
            fprintf(stderr, "kernel_launch: note: occupancy query reports %d workgroups per CU\n", per_cu);
        (void)hipGetLastError();
        grid = cus;
    }
    if (grid < 0) return;
    if (hipMemsetAsync((char*)d_ws + WS_CTL, 0, CTL_ZERO_BYTES, stream) != hipSuccess) { fprintf(stderr, "kernel_launch: hipMemsetAsync failed\n"); return; }
    Args a{};
    for (int i = 0; i < 22; ++i) a.in[i] = (const float*)d_in[i];
    a.positions = (const int*)d_in[1];
    a.out = (float*)d_out; a.ws = (unsigned char*)d_ws;
    for (int li = 0; li < N_LAUNCHES; ++li) {
        a.ph_lo = (N_LAUNCHES == 1) ? 0 : li; a.ph_hi = (N_LAUNCHES == 1) ? NPHASE : li + 1; a.li = li; a.pad = PROBE_PAD;
        hipLaunchKernelGGL(fwd_kernel, dim3(grid), dim3(NWAVES * 64), LDS_BYTES, stream, a);
        if (N_LAUNCHES > 1 && ((PHASE_REPEAT_MASK >> li) & 1)) hipLaunchKernelGGL(fwd_kernel, dim3(grid), dim3(NWAVES * 64), LDS_BYTES, stream, a);
        const hipError_t le = hipPeekAtLastError();
        if (le != hipSuccess) { fprintf(stderr, "kernel_launch: launch %d failed: %s\n", li, hipGetErrorName(le)); break; }
    }
#ifdef DBG_DUMP_OFF
    hipMemcpyAsync(d_out, (char*)d_ws + DBG_TMP_OFF, (size_t)T_TOK * 1024 * 4, hipMemcpyDeviceToDevice, stream);
#endif
}
```
